# Optimizing an MI355X kernel written in HIP

```python
import jax, jax.numpy as jnp
from jax import lax
import numpy as np

D_MODEL = 1024
BATCH = 32
SEQ = 256
DEPTH = 2
DEC_BATCH = 4
DEC_SEQ = 4096
PAST_LEN = 512

GRID_W = 64
HEAD_DIM = 64
BRANCH_WIDTH = D_MODEL // 2
A_HEADS = BRANCH_WIDTH // HEAD_DIM
A_KV_HEADS = A_HEADS // 4
A_GROUP = A_HEADS // A_KV_HEADS
B_GROUPS = 4
B_GROUP_WIDTH = BRANCH_WIDTH // B_GROUPS
POOL_WINDOWS = (2, 4, 8, 16)
C_HEADS = BRANCH_WIDTH // HEAD_DIM
C_WIDTH = C_HEADS * HEAD_DIM
NA_ROWS = 8
NA_COLS = 16
D_HEADS = 8
D_NOPE = 64
D_ROPE = 32
D_V = 64
D_WIDTH = D_HEADS * D_V
D_Q_LORA = 384
D_KV_LORA = 256
Q_BLOCK = 128
ROPE_THETA = 10000.0
EPS = 1e-6
N_EVEN = (DEPTH + 1) // 2
N_ODD = DEPTH // 2
EVEN_IN_SIZES = (A_HEADS * HEAD_DIM, A_KV_HEADS * HEAD_DIM, A_KV_HEADS * HEAD_DIM, BRANCH_WIDTH, BRANCH_WIDTH, BRANCH_WIDTH)
ODD_IN_SIZES = (C_WIDTH, C_WIDTH, C_WIDTH, C_WIDTH, D_Q_LORA, D_KV_LORA, D_ROPE, D_WIDTH)
EVEN_IN = sum(EVEN_IN_SIZES)
ODD_IN = sum(ODD_IN_SIZES)

kernel_name = 'hybrid_flow_prefix_trunk_step'


def split_last(z, sizes):
    out, off = [], 0
    for n in sizes:
        out.append(z[..., off:off + n])
        off += n
    return out


def rms_norm(x, g):
    xf = x.astype(jnp.float32)
    y = xf * lax.rsqrt(jnp.mean(xf * xf, axis=-1, keepdims=True) + EPS)
    return (y * g.astype(jnp.float32)).astype(x.dtype)


def adaln(cond, w, b):
    m = (jax.nn.silu(cond) @ w + b)[:, None, :]
    return split_last(m, (D_MODEL, D_MODEL, D_MODEL))


def pre_norm(x, g, mod):
    shift, scale, _ = mod
    return rms_norm(x, g) * (1 + scale) + shift


def post_residual(x, y, g, mod):
    return x + mod[2] * rms_norm(y, g)


def _rotate(x, ang):
    n = x.shape[-1]
    cos = jnp.cos(ang)[None, :, None, :]
    sin = jnp.sin(ang)[None, :, None, :]
    x1, x2 = x[..., :n // 2], x[..., n // 2:]
    return jnp.concatenate([x1 * cos - x2 * sin, x2 * cos + x1 * sin], axis=-1)


def axial_rope(x):
    S, R = x.shape[1], x.shape[-1]
    half = R // 2
    t = jnp.arange(S)
    inv = ROPE_THETA ** (-jnp.arange(0, half, 2, dtype=jnp.float32) / half)
    xf = x.astype(jnp.float32)
    out_r = _rotate(xf[..., :half], (t // GRID_W).astype(jnp.float32)[:, None] * inv)
    out_c = _rotate(xf[..., half:], (t % GRID_W).astype(jnp.float32)[:, None] * inv)
    return jnp.concatenate([out_r, out_c], axis=-1).astype(x.dtype)


def blocked_attention(q, k, v):
    B, S, KV, G, Dk = q.shape
    nb = S // Q_BLOCK
    scale = Dk ** -0.5
    qb = q.reshape(B, nb, Q_BLOCK, KV, G, Dk).swapaxes(0, 1)

    def one(qblk):
        s = jnp.einsum('bqkgd,bnkd->bkgqn', qblk, k, preferred_element_type=jnp.float32) * scale
        p = jax.nn.softmax(s, axis=-1).astype(v.dtype)
        return jnp.einsum('bkgqn,bnkd->bqkgd', p, v)

    o = lax.map(one, qb)
    return o.swapaxes(0, 1).reshape(B, S, KV, G, v.shape[-1])


def multiscale_pool(u, b_map, b_scale):
    B, S, _ = u.shape
    ug = u.reshape(B, S, B_GROUPS, B_GROUP_WIDTH)
    csum = jnp.pad(jnp.cumsum(ug.astype(jnp.float32), axis=1), ((0, 0), (1, 0), (0, 0), (0, 0)))
    win = jnp.array(POOL_WINDOWS, dtype=jnp.int32)[None, :]
    t = jnp.arange(S)[:, None]
    lo = jnp.clip(t - win // 2, 0, S)
    hi = jnp.clip(t + win - win // 2, 0, S)
    g = jnp.arange(B_GROUPS)[None, :]
    mean = (csum[:, hi, g] - csum[:, lo, g]) / (hi - lo).astype(jnp.float32)[None, :, :, None]
    diff = (mean - ug.astype(jnp.float32)).astype(u.dtype)
    y = jnp.einsum('bsgc,gcd->bsgd', diff, b_map)
    return y.reshape(B, S, BRANCH_WIDTH) * b_scale


def neighborhood_attention(q, k, v, k_ctx, v_ctx, rpb):
    B, S, H, D = q.shape
    L = k_ctx.shape[1]
    rows = S // GRID_W
    wr = min(NA_ROWS, rows)
    nk = wr * NA_COLS
    t = jnp.arange(S)
    qr, qc = t // GRID_W, t % GRID_W
    r0 = jnp.clip(qr - wr // 2, 0, rows - wr)
    c0 = jnp.clip(qc - NA_COLS // 2, 0, GRID_W - NA_COLS)
    kr = r0[:, None, None] + jnp.arange(wr)[None, :, None]
    kc = c0[:, None, None] + jnp.arange(NA_COLS)[None, None, :]
    idx = (kr * GRID_W + kc).reshape(S, nk)
    dr = jnp.broadcast_to(kr - qr[:, None, None] + NA_ROWS - 1, (S, wr, NA_COLS)).reshape(S, nk)
    dc = jnp.broadcast_to(kc - qc[:, None, None] + NA_COLS - 1, (S, wr, NA_COLS)).reshape(S, nk)
    nb = S // Q_BLOCK
    scale = D ** -0.5
    qb = q.reshape(B, nb, Q_BLOCK, H, D).swapaxes(0, 1)

    def one(args):
        qblk, idx_b, dr_b, dc_b = args
        kn = k[:, idx_b]
        vn = v[:, idx_b]
        s_nb = jnp.einsum('bqhd,bqnhd->bhqn', qblk, kn, preferred_element_type=jnp.float32) * scale
        s_nb = s_nb + rpb[:, dr_b, dc_b].astype(jnp.float32)
        s_cx = jnp.einsum('bqhd,blhd->bhql', qblk, k_ctx, preferred_element_type=jnp.float32) * scale
        p = jax.nn.softmax(jnp.concatenate([s_cx, s_nb], axis=-1), axis=-1).astype(v.dtype)
        return (jnp.einsum('bhql,blhd->bqhd', p[..., :L], v_ctx)
                + jnp.einsum('bhqn,bqnhd->bqhd', p[..., L:], vn))

    o = lax.map(one, (qb, idx.reshape(nb, Q_BLOCK, nk), dr.reshape(nb, Q_BLOCK, nk), dc.reshape(nb, Q_BLOCK, nk)))
    return o.swapaxes(0, 1).reshape(B, S, H, D)


def even_mixer(h, ctx_k, ctx_v, w_in, q_norm, k_norm, b_map, b_scale, w_out):
    B, S, _ = h.shape
    q, k, v, ga, ub, gb = split_last(h @ w_in, EVEN_IN_SIZES)
    q = rms_norm(q.reshape(B, S, A_HEADS, HEAD_DIM), q_norm)
    k = rms_norm(k.reshape(B, S, A_KV_HEADS, HEAD_DIM), k_norm)
    v = v.reshape(B, S, A_KV_HEADS, HEAD_DIM)
    if ctx_k is None:
        k_all, v_all = k, v
    else:
        q, k = axial_rope(q), axial_rope(k)
        k_all = jnp.concatenate([ctx_k, k], axis=1)
        v_all = jnp.concatenate([ctx_v, v], axis=1)
    o_a = blocked_attention(q.reshape(B, S, A_KV_HEADS, A_GROUP, HEAD_DIM), k_all, v_all).reshape(B, S, BRANCH_WIDTH)
    o_b = multiscale_pool(ub, b_map, b_scale)
    y = jnp.concatenate([o_a * jax.nn.silu(ga), o_b * jax.nn.silu(gb)], axis=-1) @ w_out
    return y, k, v


def odd_mixer(h, ctx_ck, ctx_cv, ctx_ckv, ctx_kpe, w_in, rpb, q_norm, w_uq, kv_norm, w_ukv, w_out):
    B, S, _ = h.shape
    qc, kc, vc, gc, cq, ckv, kpe, gd = split_last(h @ w_in, ODD_IN_SIZES)
    qc = qc.reshape(B, S, C_HEADS, HEAD_DIM)
    kc = kc.reshape(B, S, C_HEADS, HEAD_DIM)
    vc = vc.reshape(B, S, C_HEADS, HEAD_DIM)
    qd = (rms_norm(cq, q_norm) @ w_uq).reshape(B, S, D_HEADS, D_NOPE + D_ROPE)
    q_nope, q_pe = qd[..., :D_NOPE], qd[..., D_NOPE:]
    ckv = rms_norm(ckv, kv_norm)
    if ctx_ck is None:
        o_c = blocked_attention(qc[:, :, :, None, :], kc, vc)[:, :, :, 0, :]
        ckv_all, kpe_all = ckv, kpe
    else:
        o_c = neighborhood_attention(qc, kc, vc, ctx_ck, ctx_cv, rpb)
        q_pe = axial_rope(q_pe)
        kpe_rot = axial_rope(kpe[:, :, None, :])[:, :, 0, :]
        ckv_all = jnp.concatenate([ctx_ckv, ckv], axis=1)
        kpe_all = jnp.concatenate([ctx_kpe, kpe_rot], axis=1)
    N = ckv_all.shape[1]
    kv = (ckv_all @ w_ukv).reshape(B, N, D_HEADS, D_NOPE + D_V)
    k_d = jnp.concatenate([kv[..., :D_NOPE], jnp.broadcast_to(kpe_all[:, :, None, :], (B, N, D_HEADS, D_ROPE))], axis=-1)
    v_d = kv[..., D_NOPE:]
    q_d = jnp.concatenate([q_nope, q_pe], axis=-1)
    o_d = blocked_attention(q_d[:, :, :, None, :], k_d, v_d)[:, :, :, 0, :].reshape(B, S, D_WIDTH)
    o_c = o_c.reshape(B, S, C_WIDTH)
    y = jnp.concatenate([o_c * jax.nn.silu(gc), o_d * jax.nn.silu(gd)], axis=-1) @ w_out
    return y, kc, vc, ckv, kpe


def setup_inputs(seed: int = 0) -> dict:
    key = jax.random.key(seed)
    ks = jax.random.split(key, 27)
    f32 = jnp.float32

    def nrm(k, shape, scale):
        return jax.random.normal(k, shape, f32) * scale

    return {
        'x_prompt': nrm(ks[0], (BATCH, SEQ, D_MODEL), 1.0),
        'x_sample': nrm(ks[1], (DEC_BATCH, DEC_SEQ, D_MODEL), 1.0),
        'cache_a_k': nrm(ks[2], (DEC_BATCH, N_EVEN, PAST_LEN, A_KV_HEADS, HEAD_DIM), 1.0),
        'cache_a_v': nrm(ks[3], (DEC_BATCH, N_EVEN, PAST_LEN, A_KV_HEADS, HEAD_DIM), 1.0),
        'cache_c_k': nrm(ks[4], (DEC_BATCH, N_ODD, PAST_LEN, C_HEADS, HEAD_DIM), 1.0),
        'cache_c_v': nrm(ks[5], (DEC_BATCH, N_ODD, PAST_LEN, C_HEADS, HEAD_DIM), 1.0),
        'cache_d_ckv': nrm(ks[6], (DEC_BATCH, N_ODD, PAST_LEN, D_KV_LORA), 1.0),
        'cache_d_kpe': nrm(ks[7], (DEC_BATCH, N_ODD, PAST_LEN, D_ROPE), 1.0),
        'c': nrm(ks[8], (DEC_BATCH, D_MODEL), 1.0),
        'c_ctx': nrm(ks[9], (D_MODEL,), 1.0),
        'w_mod': nrm(ks[10], (DEPTH, D_MODEL, 3 * D_MODEL), D_MODEL ** -0.5),
        'b_mod': nrm(ks[11], (DEPTH, 3 * D_MODEL), 0.02),
        'g_pre': 1.0 + nrm(ks[12], (DEPTH, D_MODEL), 0.05),
        'g_post': 1.0 + nrm(ks[13], (DEPTH, D_MODEL), 0.05),
        'w_in_e': nrm(ks[14], (N_EVEN, D_MODEL, EVEN_IN), D_MODEL ** -0.5),
        'a_q_norm': 1.0 + nrm(ks[15], (N_EVEN, HEAD_DIM), 0.05),
        'a_k_norm': 1.0 + nrm(ks[16], (N_EVEN, HEAD_DIM), 0.05),
        'b_map': nrm(ks[17], (N_EVEN, B_GROUPS, B_GROUP_WIDTH, B_GROUP_WIDTH), B_GROUP_WIDTH ** -0.5),
        'b_scale': 1.0 + nrm(ks[18], (N_EVEN, BRANCH_WIDTH), 0.1),
        'w_out_e': nrm(ks[19], (N_EVEN, 2 * BRANCH_WIDTH, D_MODEL), (2 * BRANCH_WIDTH) ** -0.5),
        'w_in_o': nrm(ks[20], (N_ODD, D_MODEL, ODD_IN), D_MODEL ** -0.5),
        'c_rpb': nrm(ks[21], (N_ODD, C_HEADS, 2 * NA_ROWS - 1, 2 * NA_COLS - 1), 0.2),
        'd_q_norm': 1.0 + nrm(ks[22], (N_ODD, D_Q_LORA), 0.05),
        'd_w_uq': nrm(ks[23], (N_ODD, D_Q_LORA, D_HEADS * (D_NOPE + D_ROPE)), D_Q_LORA ** -0.5),
        'd_kv_norm': 1.0 + nrm(ks[24], (N_ODD, D_KV_LORA), 0.05),
        'd_w_ukv': nrm(ks[25], (N_ODD, D_KV_LORA, D_HEADS * (D_NOPE + D_V)), D_KV_LORA ** -0.5),
        'w_out_o': nrm(ks[26], (N_ODD, C_WIDTH + D_WIDTH, D_MODEL), (C_WIDTH + D_WIDTH) ** -0.5),
    }


def reference(x_prompt, x_sample, cache_a_k, cache_a_v, cache_c_k, cache_c_v, cache_d_ckv, cache_d_kpe,
              c, c_ctx, w_mod, b_mod, g_pre, g_post, w_in_e, a_q_norm, a_k_norm, b_map, b_scale, w_out_e,
              w_in_o, c_rpb, d_q_norm, d_w_uq, d_kv_norm, d_w_ukv, w_out_o):
    xp, xs = x_prompt, x_sample
    new_a_k, new_a_v, new_c_k, new_c_v, new_d_ckv, new_d_kpe = [], [], [], [], [], []
    for layer in range(DEPTH):
        j = layer // 2
        mod_p = adaln(c_ctx[None, :], w_mod[layer], b_mod[layer])
        mod_s = adaln(c, w_mod[layer], b_mod[layer])
        hp = pre_norm(xp, g_pre[layer], mod_p)
        hs = pre_norm(xs, g_pre[layer], mod_s)
        if layer % 2 == 0:
            yp, k_a, v_a = even_mixer(hp, None, None, w_in_e[j], a_q_norm[j], a_k_norm[j],
                                      b_map[j], b_scale[j], w_out_e[j])
            ys = even_mixer(hs, cache_a_k[:, j], cache_a_v[:, j], w_in_e[j], a_q_norm[j], a_k_norm[j],
                            b_map[j], b_scale[j], w_out_e[j])[0]
            new_a_k.append(k_a)
            new_a_v.append(v_a)
        else:
            yp, k_c, v_c, ckv, kpe = odd_mixer(hp, None, None, None, None, w_in_o[j], c_rpb[j], d_q_norm[j],
                                               d_w_uq[j], d_kv_norm[j], d_w_ukv[j], w_out_o[j])
            ys = odd_mixer(hs, cache_c_k[:, j], cache_c_v[:, j], cache_d_ckv[:, j], cache_d_kpe[:, j],
                           w_in_o[j], c_rpb[j], d_q_norm[j], d_w_uq[j], d_kv_norm[j], d_w_ukv[j], w_out_o[j])[0]
            new_c_k.append(k_c)
            new_c_v.append(v_c)
            new_d_ckv.append(ckv)
            new_d_kpe.append(kpe)
        xp = post_residual(xp, yp, g_post[layer], mod_p)
        xs = post_residual(xs, ys, g_post[layer], mod_s)
    return (xp, xs, jnp.stack(new_a_k, axis=1), jnp.stack(new_a_v, axis=1), jnp.stack(new_c_k, axis=1),
            jnp.stack(new_c_v, axis=1), jnp.stack(new_d_ckv, axis=1), jnp.stack(new_d_kpe, axis=1))
```

```cpp
#include <hip/hip_runtime.h>
#include <hip/hip_cooperative_groups.h>
#include <cstdio>
namespace cg = cooperative_groups;

#ifndef PHMASK
#define PHMASK 0xFFF
#endif
#ifndef REPEAT_MASK
#define REPEAT_MASK 0
#endif
#ifndef MK_COOP
#define MK_COOP 1
#endif

#define DI __device__ __forceinline__
#define GLOBAL __attribute__((address_space(1)))
typedef unsigned short u16;
typedef unsigned int u32;
typedef __attribute__((ext_vector_type(8))) short bf16x8;
typedef __attribute__((ext_vector_type(4))) short s16x4;
typedef __attribute__((ext_vector_type(16))) float f32x16;
typedef __attribute__((ext_vector_type(4))) float f32x4;
typedef __attribute__((ext_vector_type(2))) float f32x2;
typedef __attribute__((ext_vector_type(4))) u32 u32x4;
typedef __attribute__((ext_vector_type(2))) u32 u32x2;

constexpr int TP = 8192, TS = 16384, T = 24576, NKS = 4608, KROWS = 26624;
constexpr float EPS = 1e-6f;
constexpr float LOG2E = 1.4426950408889634f;
constexpr int NPHASE = 12;
constexpr int SMEM_BYTES = 73728;

constexpr size_t OFF_WINE = 0;
constexpr size_t OFF_WOUTE = OFF_WINE + 2304ull * 1024 * 2;
constexpr size_t OFF_WINO = OFF_WOUTE + 1024ull * 1024 * 2;
constexpr size_t OFF_WOUTO = OFF_WINO + 3328ull * 1024 * 2;
constexpr size_t OFF_WUQ = OFF_WOUTO + 1024ull * 1024 * 2;
constexpr size_t OFF_WUKVG = OFF_WUQ + 768ull * 384 * 2;
constexpr size_t OFF_WUKV = OFF_WUKVG + 1024ull * 256 * 2;
constexpr size_t OFF_WBMAP = OFF_WUKV + 1024ull * 256 * 2;
constexpr size_t OFF_MOD = OFF_WBMAP + 4ull * 128 * 128 * 2;
constexpr size_t OFF_BAR = OFF_MOD + 2ull * 5 * 3072 * 4;
constexpr size_t OFF_ROPEA = OFF_BAR + 16384;
constexpr size_t OFF_ROPED = OFF_ROPEA + 2ull * 64 * 16 * 4;
constexpr size_t OFF_CKVCTX = OFF_ROPED + 2ull * 64 * 8 * 4;
constexpr size_t OFF_KPE = OFF_CKVCTX + 2048ull * 256 * 2;
constexpr size_t OFF_SSQ = OFF_KPE + 26624ull * 32 * 2;
constexpr size_t OFF_HU = OFF_SSQ + 24576ull * 16 * 4;
constexpr size_t OFF_R = OFF_HU + 24576ull * 1024 * 2;
constexpr size_t R_QA = OFF_R;
constexpr size_t R_GA = R_QA + (size_t)T * 512 * 2;
constexpr size_t R_GB = R_GA + (size_t)T * 512 * 2;
constexpr size_t R_UB = R_GB + (size_t)T * 512 * 2;
constexpr size_t R_KA = R_UB + (size_t)T * 512 * 2;
constexpr size_t R_VTAP = R_KA + (size_t)KROWS * 128 * 2;
constexpr size_t R_VTAS = R_VTAP + 32ull * 2 * 64 * 256 * 2;
constexpr size_t R_L0END = R_VTAS + 4ull * 2 * 64 * NKS * 2;
constexpr size_t R_Y = OFF_R;
constexpr size_t R_GD = OFF_R;
constexpr size_t R_CQ = R_GD + (size_t)T * 512 * 2;
constexpr size_t R_CKV = R_CQ + (size_t)T * 384 * 2;
constexpr size_t R_Z = R_CKV + (size_t)T * 256 * 2;
constexpr size_t R_QC = R_Z;
constexpr size_t R_GC = R_QC + (size_t)T * 512 * 2;
constexpr size_t R_KC = R_GC + (size_t)T * 512 * 2;
constexpr size_t R_VTCP = R_KC + (size_t)KROWS * 512 * 2;
constexpr size_t R_VTCS = R_VTCP + 32ull * 8 * 64 * 256 * 2;
constexpr size_t R_L1END_A = R_VTCS + 4ull * 8 * 64 * NKS * 2;
constexpr size_t R_QD = R_Z;
constexpr size_t R_KD = R_QD + (size_t)T * 768 * 2;
constexpr size_t R_VTDP = R_KD + (size_t)KROWS * 512 * 2;
constexpr size_t R_VTDS = R_VTDP + 32ull * 8 * 64 * 256 * 2;
constexpr size_t R_L1END_B = R_VTDS + 4ull * 8 * 64 * NKS * 2;
constexpr size_t WS_LIMIT = 256ull * 1024 * 1024 - 16384;
static_assert(R_L0END <= WS_LIMIT && R_L1END_A <= WS_LIMIT && R_L1END_B <= WS_LIMIT, "ws overflow");
static_assert(R_Y + (size_t)T * 1024 * 4 <= R_KA, "y aliasing");
static_assert(R_Y + (size_t)T * 1024 * 4 <= WS_LIMIT, "y fits");

constexpr size_t O_Y = 0;
constexpr size_t O_AK = 25165824;
constexpr size_t O_AV = O_AK + 1048576;
constexpr size_t O_CK = O_AV + 1048576;
constexpr size_t O_CV = O_CK + 4194304;
constexpr size_t O_CKV = O_CV + 4194304;
constexpr size_t O_KPE = O_CKV + 2097152;

struct Params {
  const float *x_prompt, *x_sample, *cache_a_k, *cache_a_v, *cache_c_k, *cache_c_v, *cache_d_ckv, *cache_d_kpe;
  const float *c, *c_ctx, *w_mod, *b_mod, *g_pre, *g_post, *w_in_e, *a_q_norm, *a_k_norm, *b_map, *b_scale, *w_out_e;
  const float *w_in_o, *c_rpb, *d_q_norm, *d_w_uq, *d_kv_norm, *d_w_ukv, *w_out_o;
  float* out;
  char* ws;
  int tid, bid;
};

DI u32 pack2(float a, float b) {
  typedef __attribute__((ext_vector_type(2))) __bf16 bf2;
  bf2 v;
  v[0] = (__bf16)a;
  v[1] = (__bf16)b;
  return __builtin_bit_cast(u32, v);
}
DI u16 f2bf(float a) { return __builtin_bit_cast(u16, (__bf16)a); }
DI float bf2f(u16 u) { return __uint_as_float(((u32)u) << 16); }
DI float bflo(u32 u) { return __uint_as_float(u << 16); }
DI float bfhi(u32 u) { return __uint_as_float(u & 0xffff0000u); }
DI float silu(float x) { return x * __builtin_amdgcn_rcpf(1.f + __builtin_amdgcn_exp2f(-1.4426950408889634f * x)); }
DI f32x16 mfma32(bf16x8 a, bf16x8 b, f32x16 c) { return __builtin_amdgcn_mfma_f32_32x32x16_bf16(a, b, c, 0, 0, 0); }
DI void unpack8(u32x4 u, float* f) {
  f[0] = bflo(u[0]); f[1] = bfhi(u[0]); f[2] = bflo(u[1]); f[3] = bfhi(u[1]);
  f[4] = bflo(u[2]); f[5] = bfhi(u[2]); f[6] = bflo(u[3]); f[7] = bfhi(u[3]);
}
DI u32x4 pack8(const float* f) {
  u32x4 u;
  u[0] = pack2(f[0], f[1]); u[1] = pack2(f[2], f[3]); u[2] = pack2(f[4], f[5]); u[3] = pack2(f[6], f[7]);
  return u;
}
DI void ld8(const float* p, float* v) {
  const f32x4 a = *(const f32x4*)p, b = *(const f32x4*)(p + 4);
  v[0] = a[0]; v[1] = a[1]; v[2] = a[2]; v[3] = a[3]; v[4] = b[0]; v[5] = b[1]; v[6] = b[2]; v[7] = b[3];
}
DI void st8(float* p, const float* v) {
  f32x4 a, b;
  a[0] = v[0]; a[1] = v[1]; a[2] = v[2]; a[3] = v[3]; b[0] = v[4]; b[1] = v[5]; b[2] = v[6]; b[3] = v[7];
  *(f32x4*)p = a; *(f32x4*)(p + 4) = b;
}
DI float xhalf_max(float x) {
  const auto r = __builtin_amdgcn_permlane32_swap(__float_as_uint(x), __float_as_uint(x), false, false);
  return fmaxf(__uint_as_float(r[0]), __uint_as_float(r[1]));
}
DI float xhalf_sum(float x) {
  const auto r = __builtin_amdgcn_permlane32_swap(__float_as_uint(x), __float_as_uint(x), false, false);
  return __uint_as_float(r[0]) + __uint_as_float(r[1]);
}
DI float red8(float v) {
  v += __shfl_xor(v, 1);
  v += __shfl_xor(v, 2);
  v += __shfl_xor(v, 4);
  return v;
}
DI float wave_sum(float v) {
  v += __shfl_xor(v, 1); v += __shfl_xor(v, 2); v += __shfl_xor(v, 4);
  v += __shfl_xor(v, 8); v += __shfl_xor(v, 16); v += __shfl_xor(v, 32);
  return v;
}

struct RowInfo { int samp, b, t, krow, key, nk, mrow; };
DI RowInfo row_info(int row) {
  RowInfo r;
  if (row < TP) { r.samp = 0; r.b = row >> 8; r.t = row & 255; r.krow = row; r.key = r.t; r.nk = 256; r.mrow = 0; }
  else { int q = row - TP; r.samp = 1; r.b = q >> 12; r.t = q & 4095; r.krow = TP + r.b * NKS + 512 + r.t; r.key = 512 + r.t; r.nk = NKS; r.mrow = 1 + r.b; }
  return r;
}

enum { EPI_EVEN = 0, EPI_Y = 1, EPI_ODD = 2, EPI_Q = 3, EPI_KV = 4, EPI_KVCTX = 5, EPI_POOL = 6 };
enum { AL_PLAIN = 0, AL_POOL = 1 };
constexpr int LROW = 144;
constexpr int TILEB = 128 * LROW;
constexpr int CSTR = 132;

struct GemmJob {
  const u16* A; int lda;
  const u16* Bt;
  int K;
  int grp;
};

template <int ALOAD>
DI u32x4 load_a_chunk(const GemmJob& j, int grow, int kofs) {
  if (ALOAD == AL_PLAIN) {
    return *(const u32x4*)(j.A + (size_t)grow * j.lda + kofs);
  } else {
    const int g = j.grp;
    const int w2 = 1 << g;
    int t, S;
    if (grow < TP) { t = grow & 255; S = 256; } else { t = (grow - TP) & 4095; S = 4096; }
    const int lo = max(t - w2, 0), hi = min(t + w2, S);
    const u16* base = j.A + (size_t)(grow - t) * 512 + g * 128 + kofs;
    float s[8];
#pragma unroll
    for (int e = 0; e < 8; ++e) s[e] = 0.f;
    for (int r = lo; r < hi; ++r) {
      u32x4 u = *(const u32x4*)(base + (size_t)r * 512);
      float f[8]; unpack8(u, f);
#pragma unroll
      for (int e = 0; e < 8; ++e) s[e] += f[e];
    }
    u32x4 u = *(const u32x4*)(base + (size_t)t * 512);
    float f[8]; unpack8(u, f);
    const float inv = 1.f / (float)(hi - lo);
#pragma unroll
    for (int e = 0; e < 8; ++e) s[e] = s[e] * inv - f[e];
    return pack8(s);
  }
}

template <int EPI>
DI void gemm_epilogue(const Params& p, const GemmJob& j, int m0, int n0, const float* Cs, int tid);

struct GemmPre { u32x4 ra[4], rb[4]; };
template <int EPI, int ALOAD>
DI void gemm_tile(const Params& p, const GemmJob& j, int m0, int n0, char* smem, GemmPre& pre, bool have_pre, int nm0, int nn0) {
  const int tid = p.tid, lane = tid & 63, wid = tid >> 6;
  const int wm = wid >> 1, wn = wid & 1, l31 = lane & 31, lh = lane >> 5;
  f32x16 acc[2][2];
#pragma unroll
  for (int a = 0; a < 2; ++a)
#pragma unroll
    for (int b = 0; b < 2; ++b)
#pragma unroll
      for (int i = 0; i < 16; ++i) acc[a][b][i] = 0.f;
  const int nk = j.K >> 6;
  u32x4 ra[4], rb[4];
#define G_LOAD_T(RA, RB, mm, nn, kt)                                                                 \
  {                                                                                                  \
    _Pragma("unroll") for (int i = 0; i < 4; ++i) {                                                  \
      const int row = tid >> 1, kc = (tid & 1) * 4 + i;                                              \
      RA[i] = load_a_chunk<ALOAD>(j, (mm) + row, (kt) * 64 + kc * 8);                                \
      RB[i] = *(const u32x4*)(j.Bt + (size_t)((nn) + row) * j.K + (kt) * 64 + kc * 8);               \
    }                                                                                                \
  }
#define G_LOAD(kt) G_LOAD_T(ra, rb, m0, n0, kt)
#define G_STORE(st)                                                                                  \
  {                                                                                                  \
    char* sa = smem + (st) * 2 * TILEB;                                                              \
    char* sb = sa + TILEB;                                                                           \
    _Pragma("unroll") for (int i = 0; i < 4; ++i) {                                                  \
      const int row = tid >> 1, kc = (tid & 1) * 4 + i;                                              \
      *(u32x4*)(sa + row * LROW + kc * 16) = ra[i];                                                  \
      *(u32x4*)(sb + row * LROW + kc * 16) = rb[i];                                                  \
    }                                                                                                \
  }
  if (have_pre) {
#pragma unroll
    for (int i = 0; i < 4; ++i) { ra[i] = pre.ra[i]; rb[i] = pre.rb[i]; }
  } else {
    G_LOAD(0);
  }
  G_STORE(0);
  if (nk > 1) G_LOAD(1);
  __syncthreads();
  for (int kt = 0; kt < nk; ++kt) {
    __builtin_amdgcn_sched_barrier(0);
    const char* sa = smem + (kt & 1) * 2 * TILEB;
    const char* sb = sa + TILEB;
    bf16x8 af[2][2], bfr[2][2];
#define LDFRAG(buf, kk)                                                                              \
  {                                                                                                  \
    _Pragma("unroll") for (int mt = 0; mt < 2; ++mt) af[buf][mt] = *(const bf16x8*)(sa + (wm * 64 + mt * 32 + l31) * LROW + (kk) * 32 + lh * 16); \
    _Pragma("unroll") for (int nt = 0; nt < 2; ++nt) bfr[buf][nt] = *(const bf16x8*)(sb + (wn * 64 + nt * 32 + l31) * LROW + (kk) * 32 + lh * 16); \
  }
    LDFRAG(0, 0);
#pragma unroll
    for (int kk = 0; kk < 4; ++kk) {
      if (kk < 3) LDFRAG((kk + 1) & 1, kk + 1);
      __builtin_amdgcn_sched_barrier(0);
#pragma unroll
      for (int mt = 0; mt < 2; ++mt)
#pragma unroll
        for (int nt = 0; nt < 2; ++nt) acc[mt][nt] = mfma32(af[kk & 1][mt], bfr[kk & 1][nt], acc[mt][nt]);
      __builtin_amdgcn_sched_barrier(0);
    }
#undef LDFRAG
    __builtin_amdgcn_sched_barrier(0);
    if (kt + 1 < nk) {
      G_STORE((kt + 1) & 1);
      if (kt + 2 < nk) G_LOAD(kt + 2);
    }
    __builtin_amdgcn_sched_barrier(0);
    __syncthreads();
  }
#undef G_STORE
  float* Cs = (float*)smem;
#pragma unroll
  for (int mt = 0; mt < 2; ++mt)
#pragma unroll
    for (int nt = 0; nt < 2; ++nt)
#pragma unroll
      for (int i = 0; i < 16; ++i) {
        const int row = wm * 64 + mt * 32 + (i & 3) + 8 * (i >> 2) + 4 * lh;
        const int col = wn * 64 + nt * 32 + l31;
        Cs[row * CSTR + col] = acc[mt][nt][i];
      }
  __syncthreads();
  if (nm0 >= 0) G_LOAD_T(pre.ra, pre.rb, nm0, nn0, 0);
  __builtin_amdgcn_sched_barrier(0);
  gemm_epilogue<EPI>(p, j, m0, n0, Cs, tid);
  __syncthreads();
#undef G_LOAD
#undef G_LOAD_T
}

DI void pool_tile(const Params& p, int m0, int g, char* smem) {
  const int tid = p.tid, lane = tid & 63, wid = tid >> 6;
  const int wm = wid >> 1, wn = wid & 1, l31 = lane & 31, lh = lane >> 5;
  const u16* Ub = (const u16*)(p.ws + R_UB);
  const u16* Bt = (const u16*)(p.ws + OFF_WBMAP) + (size_t)g * 128 * 128;
  const int w2 = 1 << g;
  const int row = tid >> 1, kcb = (tid & 1) * 4;
#pragma unroll
  for (int kt = 0; kt < 2; ++kt)
#pragma unroll
    for (int i = 0; i < 4; ++i)
      *(u32x4*)(smem + kt * 2 * TILEB + TILEB + row * LROW + (kcb + i) * 16) = *(const u32x4*)(Bt + (size_t)row * 128 + kt * 64 + (kcb + i) * 8);
  {
    const int grow = m0 + row;
    int t, S;
    if (grow < TP) { t = grow & 255; S = 256; } else { t = (grow - TP) & 4095; S = 4096; }
    const float inv = 1.f / (float)(min(t + w2, S) - max(t - w2, 0));
#pragma unroll 1
    for (int q = 0; q < 8; ++q) {
      const int kt = q >> 2, kc = kcb + (q & 3);
      const u16* base = Ub + (size_t)(grow - t) * 512 + g * 128 + kt * 64 + kc * 8;
      u32x4 u[16];
#pragma unroll
      for (int r = 0; r < 16; ++r)
        if (r < 2 * w2) {
          const int rc = min(max(t - w2 + r, 0), S - 1);
          u[r] = *(const u32x4*)(base + (size_t)rc * 512);
        }
      const u32x4 uo = *(const u32x4*)(base + (size_t)t * 512);
      float sacc[8];
#pragma unroll
      for (int e = 0; e < 8; ++e) sacc[e] = 0.f;
#pragma unroll
      for (int r = 0; r < 16; ++r)
        if (r < 2 * w2) {
          const int rr = t - w2 + r;
          const float ok = (rr >= 0 && rr < S) ? 1.f : 0.f;
          float x[8]; unpack8(u[r], x);
#pragma unroll
          for (int e = 0; e < 8; ++e) sacc[e] += ok * x[e];
        }
      float f[8]; unpack8(uo, f);
#pragma unroll
      for (int e = 0; e < 8; ++e) sacc[e] = sacc[e] * inv - f[e];
      *(u32x4*)(smem + kt * 2 * TILEB + row * LROW + kc * 16) = pack8(sacc);
    }
  }
  __syncthreads();
  f32x16 acc[2][2];
#pragma unroll
  for (int a = 0; a < 2; ++a)
#pragma unroll
    for (int b = 0; b < 2; ++b)
#pragma unroll
      for (int i = 0; i < 16; ++i) acc[a][b][i] = 0.f;
#pragma unroll
  for (int kt = 0; kt < 2; ++kt) {
    const char* sa = smem + kt * 2 * TILEB;
    const char* sb = sa + TILEB;
#pragma unroll
    for (int kk = 0; kk < 4; ++kk) {
      bf16x8 af[2], bfr[2];
#pragma unroll
      for (int mt = 0; mt < 2; ++mt) af[mt] = *(const bf16x8*)(sa + (wm * 64 + mt * 32 + l31) * LROW + kk * 32 + lh * 16);
#pragma unroll
      for (int nt = 0; nt < 2; ++nt) bfr[nt] = *(const bf16x8*)(sb + (wn * 64 + nt * 32 + l31) * LROW + kk * 32 + lh * 16);
#pragma unroll
      for (int mt = 0; mt < 2; ++mt)
#pragma unroll
        for (int nt = 0; nt < 2; ++nt) acc[mt][nt] = mfma32(af[mt], bfr[nt], acc[mt][nt]);
    }
  }
  __syncthreads();
  float* Cs = (float*)smem;
#pragma unroll
  for (int mt = 0; mt < 2; ++mt)
#pragma unroll
    for (int nt = 0; nt < 2; ++nt)
#pragma unroll
      for (int i = 0; i < 16; ++i) {
        const int r2 = wm * 64 + mt * 32 + (i & 3) + 8 * (i >> 2) + 4 * lh;
        const int c2 = wn * 64 + nt * 32 + l31;
        Cs[r2 * CSTR + c2] = acc[mt][nt][i];
      }
  __syncthreads();
  GemmJob j; j.A = nullptr; j.lda = 0; j.Bt = nullptr; j.K = 128; j.grp = g;
  gemm_epilogue<EPI_POOL>(p, j, m0, 0, Cs, tid);
  __syncthreads();
}

DI void store_vt_tile(const float* Cs, int m0, int tid, u16* vtP, u16* vtS, int nheads, int head0, const float* rowscale_ssq, int ssq_ofs, int ssq_n, float ssq_div, bool ctx_rows) {
  const int r = tid & 127, half = tid >> 7;
  int b, key, nk; u16* base;
  if (ctx_rows) {
    const int i = m0 + r; b = i >> 9; key = i & 511; nk = NKS; base = vtS;
  } else {
    RowInfo ri = row_info(m0 + r); b = ri.b; key = ri.key; nk = ri.nk; base = ri.samp ? vtS : vtP;
  }
  float rs = 1.f;
  if (rowscale_ssq) {
    float s = 0.f;
    for (int q = 0; q < ssq_n; ++q) s += rowscale_ssq[(size_t)(m0 + r) * 16 + ssq_ofs + q];
    rs = rsqrtf(s / ssq_div + EPS);
  }
  const int head = head0 + half;
  u16* dst = base + ((size_t)(b * nheads + head) * 64) * nk + key;
#pragma unroll 4
  for (int j4 = 0; j4 < 16; ++j4) {
    f32x4 f = *(const f32x4*)(Cs + r * CSTR + half * 64 + j4 * 4);
#pragma unroll
    for (int e = 0; e < 4; ++e) dst[(size_t)(j4 * 4 + e) * nk] = f2bf(f[e] * rs);
  }
}

template <int EPI>
DI void gemm_epilogue(const Params& p, const GemmJob& j, int m0, int n0, const float* Cs, int tid) {
  char* ws = p.ws;
  const int ntile = n0 >> 7;
  if (EPI == EPI_Y) {
    u16* y = (u16*)(ws + R_Y);
#pragma unroll
    for (int it = 0; it < 8; ++it) {
      const int item = it * 256 + tid, row = item >> 4, col0 = (item & 15) * 8;
      float v[8];
      ld8(Cs + row * CSTR + col0, v);
      *(u32x4*)(y + (size_t)(m0 + row) * 1024 + n0 + col0) = pack8(v);
    }
    return;
  }
  if (EPI == EPI_POOL) {
    const int g = j.grp;
    const u16* Gb = (const u16*)(ws + R_GB);
    u16* U = (u16*)(ws + OFF_HU);
#pragma unroll
    for (int it = 0; it < 8; ++it) {
      const int item = it * 256 + tid, row = item >> 4, col0 = (item & 15) * 8;
      const int grow = m0 + row, gc = g * 128 + col0;
      float v[8], gt[8];
      ld8(Cs + row * CSTR + col0, v);
      unpack8(*(const u32x4*)(Gb + (size_t)grow * 512 + gc), gt);
#pragma unroll
      for (int e = 0; e < 8; ++e) v[e] = v[e] * p.b_scale[gc + e] * gt[e];
      *(u32x4*)(U + (size_t)grow * 1024 + 512 + gc) = pack8(v);
    }
    return;
  }
  if (EPI == EPI_EVEN) {
    if (ntile == 5) {
#pragma unroll
      for (int it = 0; it < 8; ++it) {
        const int item = it * 256 + tid, row = item >> 4, col0 = (item & 15) * 8;
        const int grow = m0 + row;
        if (grow < TP) {
          float* d = p.out + O_AV + (size_t)grow * 128 + col0;
          *(f32x4*)d = *(const f32x4*)(Cs + row * CSTR + col0); *(f32x4*)(d + 4) = *(const f32x4*)(Cs + row * CSTR + col0 + 4);
        }
      }
      store_vt_tile(Cs, m0, tid, (u16*)(ws + R_VTAP), (u16*)(ws + R_VTAS), 2, 0, nullptr, 0, 0, 1.f, false);
      return;
    }
    const float* ropec = (const float*)(ws + OFF_ROPEA);
    const float* ropes = ropec + 64 * 16;
    float gnv[8], gpv[8];
    {
      const float* gn0 = (ntile < 4) ? p.a_q_norm : p.a_k_norm;
      const int d0c = (n0 + (tid & 15) * 8) & 63;
#pragma unroll
      for (int e = 0; e < 8; ++e) { gnv[e] = (ntile <= 4) ? gn0[d0c + e] : 0.f; gpv[e] = (ntile <= 4) ? gn0[(d0c ^ 16) + e] : 0.f; }
    }
#pragma unroll
    for (int it = 0; it < 8; ++it) {
      const int item = it * 256 + tid, row = item >> 4, col0 = (item & 15) * 8;
      const int grow = m0 + row, gcol = n0 + col0;
      float v[8];
      ld8(Cs + row * CSTR + col0, v);
      if (ntile <= 4) {
        const bool isq = ntile < 4;
        const RowInfo ri = row_info(grow);
        const int d0 = gcol & 63;
        float ss = 0.f;
#pragma unroll
        for (int e = 0; e < 8; ++e) ss += v[e] * v[e];
        ss = red8(ss);
        const float r = rsqrtf(ss * (1.f / 64.f) + EPS);
        float nv[8];
#pragma unroll
        for (int e = 0; e < 8; ++e) nv[e] = v[e] * r * gnv[e];
        if (!isq && !ri.samp) {
          float* d = p.out + O_AK + (size_t)grow * 128 + (gcol - 512);
          st8(d, nv);
        }
        if (ri.samp) {
          const int pc = col0 ^ 16, pd0 = d0 ^ 16;
          float pv[8];
          ld8(Cs + row * CSTR + pc, pv);
          const int pos = (d0 < 32) ? (ri.t >> 6) : (ri.t & 63);
          const int i0 = d0 & 15;
          const float sgn = (d0 & 16) ? 1.f : -1.f;
#pragma unroll
          for (int e = 0; e < 8; ++e) {
            const float pn = pv[e] * r * gpv[e];
            const float cs = ropec[pos * 16 + i0 + e], sn = ropes[pos * 16 + i0 + e];
            nv[e] = nv[e] * cs + sgn * pn * sn;
          }
        }
        if (isq) *(u32x4*)((u16*)(ws + R_QA) + (size_t)grow * 512 + gcol) = pack8(nv);
        else *(u32x4*)((u16*)(ws + R_KA) + (size_t)ri.krow * 128 + (gcol - 512)) = pack8(nv);
      } else if (ntile < 10) {
#pragma unroll
        for (int e = 0; e < 8; ++e) v[e] = silu(v[e]);
        *(u32x4*)((u16*)(ws + R_GA) + (size_t)grow * 512 + (gcol - 768)) = pack8(v);
      } else if (ntile < 14) {
        *(u32x4*)((u16*)(ws + R_UB) + (size_t)grow * 512 + (gcol - 1280)) = pack8(v);
      } else {
#pragma unroll
        for (int e = 0; e < 8; ++e) v[e] = silu(v[e]);
        *(u32x4*)((u16*)(ws + R_GB) + (size_t)grow * 512 + (gcol - 1792)) = pack8(v);
      }
    }
    return;
  }
  if (EPI == EPI_ODD) {
    if (ntile >= 8 && ntile < 12) {
#pragma unroll
      for (int it = 0; it < 8; ++it) {
        const int item = it * 256 + tid, row = item >> 4, col0 = (item & 15) * 8;
        const int grow = m0 + row;
        if (grow < TP) {
          float* d = p.out + O_CV + (size_t)grow * 512 + (n0 - 1024) + col0;
          *(f32x4*)d = *(const f32x4*)(Cs + row * CSTR + col0); *(f32x4*)(d + 4) = *(const f32x4*)(Cs + row * CSTR + col0 + 4);
        }
      }
      store_vt_tile(Cs, m0, tid, (u16*)(ws + R_VTCP), (u16*)(ws + R_VTCS), 8, (n0 - 1024) >> 6, nullptr, 0, 0, 1.f, false);
      return;
    }
    const float* ropec = (const float*)(ws + OFF_ROPED);
    const float* ropes = ropec + 64 * 8;
    float* ssq = (float*)(ws + OFF_SSQ);
#pragma unroll
    for (int it = 0; it < 8; ++it) {
      const int item = it * 256 + tid, row = item >> 4, c8 = item & 15, col0 = c8 * 8;
      const int grow = m0 + row, gcol = n0 + col0;
      float v[8];
      ld8(Cs + row * CSTR + col0, v);
      if (ntile < 4) {
        *(u32x4*)((u16*)(ws + R_QC) + (size_t)grow * 512 + gcol) = pack8(v);
      } else if (ntile < 8) {
        const RowInfo ri = row_info(grow);
        if (!ri.samp) { float* d = p.out + O_CK + (size_t)grow * 512 + (gcol - 512); st8(d, v); }
        *(u32x4*)((u16*)(ws + R_KC) + (size_t)ri.krow * 512 + (gcol - 512)) = pack8(v);
      } else if (ntile < 16) {
#pragma unroll
        for (int e = 0; e < 8; ++e) v[e] = silu(v[e]);
        *(u32x4*)((u16*)(ws + R_GC) + (size_t)grow * 512 + (gcol - 1536)) = pack8(v);
      } else if (ntile < 20) {
#pragma unroll
        for (int e = 0; e < 8; ++e) v[e] = silu(v[e]);
        *(u32x4*)((u16*)(ws + R_GD) + (size_t)grow * 512 + (gcol - 2048)) = pack8(v);
      } else if (ntile < 23) {
        float ss = 0.f;
#pragma unroll
        for (int e = 0; e < 8; ++e) ss += v[e] * v[e];
        ss = red8(ss);
        if ((c8 & 7) == 0) ssq[(size_t)grow * 16 + ((gcol - 2560) >> 6)] = ss;
        *(u32x4*)((u16*)(ws + R_CQ) + (size_t)grow * 384 + (gcol - 2560)) = pack8(v);
      } else if (ntile < 25) {
        float ss = 0.f;
#pragma unroll
        for (int e = 0; e < 8; ++e) ss += v[e] * v[e];
        ss = red8(ss);
        if ((c8 & 7) == 0) ssq[(size_t)grow * 16 + 8 + ((gcol - 2944) >> 6)] = ss;
        *(u32x4*)((u16*)(ws + R_CKV) + (size_t)grow * 256 + (gcol - 2944)) = pack8(v);
        if (grow < TP) { float* d = p.out + O_CKV + (size_t)grow * 256 + (gcol - 2944); st8(d, v); }
      } else {
        if (c8 < 4) {
          const RowInfo ri = row_info(grow);
          const int d0 = col0;
          if (!ri.samp) { float* d = p.out + O_KPE + (size_t)grow * 32 + d0; st8(d, v); }
          else {
            const int pc = col0 ^ 8;
            float pv[8];
            ld8(Cs + row * CSTR + pc, pv);
            const int pos = (d0 < 16) ? (ri.t >> 6) : (ri.t & 63);
            const float sgn = (d0 & 8) ? 1.f : -1.f;
#pragma unroll
            for (int e = 0; e < 8; ++e) {
              const float cs = ropec[pos * 8 + e], sn = ropes[pos * 8 + e];
              v[e] = v[e] * cs + sgn * pv[e] * sn;
            }
          }
          *(u32x4*)((u16*)(ws + OFF_KPE) + (size_t)ri.krow * 32 + d0) = pack8(v);
        }
      }
    }
    return;
  }
  if (EPI == EPI_Q) {
    const float* ropec = (const float*)(ws + OFF_ROPED);
    const float* ropes = ropec + 64 * 8;
    const float* ssq = (const float*)(ws + OFF_SSQ);
    u16* Qd = (u16*)(ws + R_QD);
#pragma unroll
    for (int it = 0; it < 8; ++it) {
      const int item = it * 256 + tid, row = item >> 4, col0 = (item & 15) * 8;
      const int grow = m0 + row, gcol = n0 + col0;
      float s = 0.f;
#pragma unroll
      for (int q = 0; q < 6; ++q) s += ssq[(size_t)grow * 16 + q];
      const float r = rsqrtf(s * (1.f / 384.f) + EPS);
      float v[8];
      ld8(Cs + row * CSTR + col0, v);
#pragma unroll
      for (int e = 0; e < 8; ++e) v[e] *= r;
      if (gcol < 512) {
        const int head = gcol >> 6, d = gcol & 63;
        *(u32x4*)(Qd + (size_t)grow * 768 + head * 96 + d) = pack8(v);
      } else {
        const int m = gcol - 512, head = m >> 5, d0 = m & 31;
        const RowInfo ri = row_info(grow);
        if (ri.samp) {
          const int pc = col0 ^ 8;
          float pv[8];
          ld8(Cs + row * CSTR + pc, pv);
          const int pos = (d0 < 16) ? (ri.t >> 6) : (ri.t & 63);
          const float sgn = (d0 & 8) ? 1.f : -1.f;
#pragma unroll
          for (int e = 0; e < 8; ++e) {
            const float cs = ropec[pos * 8 + e], sn = ropes[pos * 8 + e];
            v[e] = v[e] * cs + sgn * (pv[e] * r) * sn;
          }
        }
        *(u32x4*)(Qd + (size_t)grow * 768 + head * 96 + 64 + d0) = pack8(v);
      }
    }
    return;
  }
  if (EPI == EPI_KV || EPI == EPI_KVCTX) {
    const float* ssq = (const float*)(ws + OFF_SSQ);
    if (n0 >= 512) {
      store_vt_tile(Cs, m0, tid, (u16*)(ws + R_VTDP), (u16*)(ws + R_VTDS), 8, (n0 - 512) >> 6,
                    EPI == EPI_KV ? ssq : nullptr, 8, 4, 256.f, EPI == EPI_KVCTX);
      return;
    }
    u16* Kd = (u16*)(ws + R_KD);
#pragma unroll
    for (int it = 0; it < 8; ++it) {
      const int item = it * 256 + tid, row = item >> 4, col0 = (item & 15) * 8;
      const int grow = m0 + row, gcol = n0 + col0;
      float r = 1.f; int krow;
      if (EPI == EPI_KV) {
        float s = 0.f;
#pragma unroll
        for (int q = 0; q < 4; ++q) s += ssq[(size_t)grow * 16 + 8 + q];
        r = rsqrtf(s * (1.f / 256.f) + EPS);
        krow = row_info(grow).krow;
      } else {
        krow = TP + (grow >> 9) * NKS + (grow & 511);
      }
      float v[8];
      ld8(Cs + row * CSTR + col0, v);
#pragma unroll
      for (int e = 0; e < 8; ++e) v[e] *= r;
      *(u32x4*)(Kd + (size_t)krow * 512 + gcol) = pack8(v);
    }
    return;
  }
}

struct AttnJob {
  const u16* Q; int q_stride;
  const u16* K; int k_stride;
  const u16* K2;
  const u16* Vt; int nk;
  const u16* G;
  u16* U;
  int qrow0;
  int ntiles;
  float sc;
  int qt2; const float* rpb;
  int tid;
};

constexpr int VROW = 136;
template <int DK>
struct AttnCfg { static constexpr int KROW = DK * 2 + 16; static constexpr int STAGE = 64 * (KROW + VROW); static constexpr int KCH = DK / 8; static constexpr int NKL = (64 * KCH) / 256; };
constexpr int RPB_OFF = 45056;

template <int DK, bool NA>
DI void attn_item(const AttnJob& j, char* smem) {
  typedef AttnCfg<DK> C;
  const int tid = j.tid, lane = tid & 63, wid = tid >> 6, l31 = lane & 31, lh = lane >> 5;
  int r0e = 0;
  float* rpbl = (float*)(smem + RPB_OFF);
  if (NA) {
    r0e = min(max(2 * j.qt2 - 4, 0), 56);
    for (int i = tid; i < 465; i += 256) rpbl[i] = j.rpb[i] * LOG2E;
  }
  bf16x8 qf[DK / 16];
  {
    const u16* qp = j.Q + (size_t)(j.qrow0 + wid * 32 + l31) * j.q_stride + lh * 8;
#pragma unroll
    for (int kk = 0; kk < DK / 16; ++kk) qf[kk] = *(const bf16x8*)(qp + kk * 16);
  }
  f32x16 o[2];
#pragma unroll
  for (int a = 0; a < 2; ++a)
#pragma unroll
    for (int i = 0; i < 16; ++i) o[a][i] = 0.f;
  float m_run = -INFINITY, l_run = 0.f;
  u32x4 rk[C::NKL], rv[2];
#define KEY0(jt) (NA ? ((jt) < 8 ? (jt) * 64 : 512 + (r0e + (jt) - 8) * 64) : (jt) * 64)
#define A_LOAD(jt)                                                                                   \
  {                                                                                                  \
    const int key0 = KEY0(jt);                                                                       \
    _Pragma("unroll") for (int i = 0; i < C::NKL; ++i) {                                             \
      const int c = tid + 256 * i, row = c / C::KCH, ch = c % C::KCH;                                \
      if (DK == 96 && ch >= 8) rk[i] = *(const u32x4*)(j.K2 + (size_t)(key0 + row) * 32 + (ch - 8) * 8); \
      else rk[i] = *(const u32x4*)(j.K + (size_t)(key0 + row) * j.k_stride + ch * 8);                \
    }                                                                                                \
    _Pragma("unroll") for (int i = 0; i < 2; ++i) {                                                  \
      const int c = tid + 256 * i, row = c >> 3, ch = c & 7;                                         \
      rv[i] = *(const u32x4*)(j.Vt + (size_t)row * j.nk + key0 + ch * 8);                            \
    }                                                                                                \
  }
#define A_STORE(st)                                                                                  \
  {                                                                                                  \
    char* sk = smem + (st) * C::STAGE;                                                               \
    char* sv = sk + 64 * C::KROW;                                                                    \
    _Pragma("unroll") for (int i = 0; i < C::NKL; ++i) {                                             \
      const int c = tid + 256 * i, row = c / C::KCH, ch = c % C::KCH;                                \
      *(u32x4*)(sk + row * C::KROW + ch * 16) = rk[i];                                               \
    }                                                                                                \
    _Pragma("unroll") for (int i = 0; i < 2; ++i) {                                                  \
      const int c = tid + 256 * i, row = c >> 3, ch = c & 7;                                         \
      u32x2 lo, hi; lo[0] = rv[i][0]; lo[1] = rv[i][1]; hi[0] = rv[i][2]; hi[1] = rv[i][3];          \
      *(u32x2*)(sv + row * VROW + ch * 16) = lo;                                                     \
      *(u32x2*)(sv + row * VROW + ch * 16 + 8) = hi;                                                 \
    }                                                                                                \
  }
  A_LOAD(0);
  A_STORE(0);
  __syncthreads();
  const int qr = 2 * j.qt2 + (wid >> 1), qc = (wid & 1) * 32 + l31;
  const int r0 = min(max(qr - 4, 0), 56), c0 = min(max(qc - 8, 0), 48);
  for (int jt = 0; jt < j.ntiles; ++jt) {
    if (jt + 1 < j.ntiles) A_LOAD(jt + 1);
    __builtin_amdgcn_sched_barrier(0);
    const char* sk = smem + (jt & 1) * C::STAGE;
    const char* sv = sk + 64 * C::KROW;
    bool skip_tile = false;
    if (NA && jt >= 8) { const int kr_ = r0e + jt - 8; skip_tile = !((kr_ >= r0) && (kr_ < r0 + 8)); }
    if (!skip_tile) {
    f32x16 s[2];
#pragma unroll
    for (int a = 0; a < 2; ++a)
#pragma unroll
      for (int i = 0; i < 16; ++i) s[a][i] = 0.f;
    {
      bf16x8 kf[2][2];
#define LDK(buf, kk) { _Pragma("unroll") for (int mt = 0; mt < 2; ++mt) kf[buf][mt] = *(const bf16x8*)(sk + (mt * 32 + l31) * C::KROW + (kk) * 32 + lh * 16); }
      LDK(0, 0);
      __builtin_amdgcn_s_setprio(1);
#pragma unroll
      for (int kk = 0; kk < DK / 16; ++kk) {
        if (kk + 1 < DK / 16) LDK((kk + 1) & 1, kk + 1);
        __builtin_amdgcn_sched_barrier(0);
#pragma unroll
        for (int mt = 0; mt < 2; ++mt) s[mt] = mfma32(kf[kk & 1][mt], qf[kk], s[mt]);
        __builtin_amdgcn_sched_barrier(0);
      }
      __builtin_amdgcn_s_setprio(0);
#undef LDK
    }
    u32x4 vfr[2][2];
#define LDV(buf, sp)                                                                                 \
  {                                                                                                  \
    _Pragma("unroll") for (int dt = 0; dt < 2; ++dt) {                                               \
      const char* vp = sv + (dt * 32 + l31) * VROW + (16 * (sp) + 4 * lh) * 2;                       \
      const u32x2 lo = *(const u32x2*)vp, hi = *(const u32x2*)(vp + 16);                             \
      vfr[buf][dt][0] = lo[0]; vfr[buf][dt][1] = lo[1]; vfr[buf][dt][2] = hi[0]; vfr[buf][dt][3] = hi[1]; \
    }                                                                                                \
  }
    LDV(0, 0);
    __builtin_amdgcn_sched_barrier(0);
    float mxs;
    if (NA && jt >= 8) {
      const int kr = r0e + jt - 8;
      const bool rowok = (kr >= r0) && (kr < r0 + 8);
      const float* bl = rpbl + (kr - qr + 7) * 31 + (15 - qc);
      float mx = -INFINITY;
#pragma unroll
      for (int mt = 0; mt < 2; ++mt)
#pragma unroll
        for (int i = 0; i < 16; ++i) {
          const int kc = 32 * mt + (i & 3) + 8 * (i >> 2) + 4 * lh;
          const bool ok = rowok && (kc >= c0) && (kc < c0 + 16);
          float bias = 0.f;
          if (ok) bias = bl[kc];
          const float t = ok ? (s[mt][i] * j.sc + bias) : -INFINITY;
          s[mt][i] = t;
          mx = fmaxf(mx, t);
        }
      mxs = xhalf_max(mx);
    } else {
      float mx = -INFINITY;
#pragma unroll
      for (int mt = 0; mt < 2; ++mt)
#pragma unroll
        for (int i = 0; i < 16; ++i) mx = fmaxf(mx, s[mt][i]);
      mx = xhalf_max(mx);
      mxs = mx * j.sc;
    }
    if (__any(mxs > m_run + 8.f)) {
      const float m_new = fmaxf(m_run, mxs);
      const float alpha = __builtin_amdgcn_exp2f(m_run - m_new);
      m_run = m_new;
      l_run *= alpha;
      const f32x2 a2 = {alpha, alpha};
#pragma unroll
      for (int a = 0; a < 2; ++a)
#pragma unroll
        for (int i = 0; i < 8; ++i) {
          f32x2 v = {o[a][2 * i], o[a][2 * i + 1]};
          v = v * a2;
          o[a][2 * i] = v[0]; o[a][2 * i + 1] = v[1];
        }
    }
    {
      f32x2 ps2 = {0.f, 0.f};
      const f32x2 nm2 = {-m_run, -m_run};
      const bool raw = !(NA && jt >= 8);
      const float scl = raw ? j.sc : 1.f;
      const f32x2 sc2 = {scl, scl};
#pragma unroll
      for (int mt = 0; mt < 2; ++mt)
#pragma unroll
        for (int i = 0; i < 8; ++i) {
          f32x2 v = {s[mt][2 * i], s[mt][2 * i + 1]};
          v = v * sc2 + nm2;
          f32x2 e = {__builtin_amdgcn_exp2f(v[0]), __builtin_amdgcn_exp2f(v[1])};
          s[mt][2 * i] = e[0]; s[mt][2 * i + 1] = e[1];
          ps2 += e;
        }
      l_run += ps2[0] + ps2[1];
    }
    __builtin_amdgcn_s_setprio(1);
#pragma unroll
    for (int sp = 0; sp < 4; ++sp) {
      const int mt = sp >> 1, s8 = (sp & 1) * 8;
      u32x4 pu;
      pu[0] = pack2(s[mt][s8 + 0], s[mt][s8 + 1]); pu[1] = pack2(s[mt][s8 + 2], s[mt][s8 + 3]);
      pu[2] = pack2(s[mt][s8 + 4], s[mt][s8 + 5]); pu[3] = pack2(s[mt][s8 + 6], s[mt][s8 + 7]);
      const bf16x8 pb = __builtin_bit_cast(bf16x8, pu);
      if (sp + 1 < 4) LDV((sp + 1) & 1, sp + 1);
      __builtin_amdgcn_sched_barrier(0);
#pragma unroll
      for (int dt = 0; dt < 2; ++dt) o[dt] = mfma32(__builtin_bit_cast(bf16x8, vfr[sp & 1][dt]), pb, o[dt]);
      __builtin_amdgcn_sched_barrier(0);
    }
    __builtin_amdgcn_s_setprio(0);
#undef LDV
    }
    __builtin_amdgcn_sched_barrier(0);
    if (jt + 1 < j.ntiles) A_STORE((jt + 1) & 1);
    __syncthreads();
  }
#undef A_LOAD
#undef A_STORE
#undef KEY0
  const float lt = xhalf_sum(l_run);
  const float inv = 1.f / lt;
  const int qrow = j.qrow0 + wid * 32 + l31;
  const u16* gp = j.G + (size_t)qrow * 512;
  u16* up = j.U + (size_t)qrow * 1024;
#pragma unroll
  for (int dt = 0; dt < 2; ++dt)
#pragma unroll
    for (int g4 = 0; g4 < 4; ++g4) {
      const int d = dt * 32 + 8 * g4 + 4 * lh;
      u32x2 gg = *(const u32x2*)(gp + d);
      u32x2 ov;
      ov[0] = pack2(o[dt][g4 * 4 + 0] * inv * bflo(gg[0]), o[dt][g4 * 4 + 1] * inv * bfhi(gg[0]));
      ov[1] = pack2(o[dt][g4 * 4 + 2] * inv * bflo(gg[1]), o[dt][g4 * 4 + 3] * inv * bfhi(gg[1]));
      *(u32x2*)(up + d) = ov;
    }
}

DI int perm_src(int perm, int n) {
  switch (perm) {
    case 0: return n;
    case 1:
      if (n < 2048) return n;
      if (n < 2560) return 2720 + (n - 2048);
      if (n < 2944) return 2048 + (n - 2560);
      if (n < 3200) return 2432 + (n - 2944);
      if (n < 3232) return 2688 + (n - 3200);
      return -1;
    case 2:
      if (n < 512) return (n >> 6) * 96 + (n & 63);
      return ((n - 512) >> 5) * 96 + 64 + ((n - 512) & 31);
    default:
      if (n < 512) return (n >> 6) * 128 + (n & 63);
      return ((n - 512) >> 6) * 128 + 64 + ((n - 512) & 63);
  }
}

DI void transpose_tile(const float* src, const float* g, u16* dst, int K, int Nsrc, int perm, int k0, int n0, char* smem, int tid) {
  float* tile = (float*)smem;
  {
    const int nn = tid & 63, kq = tid >> 6;
    const int sc = perm_src(perm, n0 + nn);
    float tv[16];
#pragma unroll
    for (int i = 0; i < 16; ++i) {
      const int k = kq + 4 * i;
      tv[i] = (sc >= 0) ? __builtin_nontemporal_load(&src[(size_t)(k0 + k) * Nsrc + sc]) : 0.f;
    }
#pragma unroll
    for (int i = 0; i < 16; ++i) {
      const int k = kq + 4 * i;
      float v = tv[i];
      if (g) v *= g[k0 + k];
      tile[k * 65 + nn] = v;
    }
  }
  __syncthreads();
  {
    const int kp = tid & 31, nb = tid >> 5;
#pragma unroll
    for (int i = 0; i < 8; ++i) {
      const int n = nb + 8 * i;
      const u32 v = pack2(tile[(2 * kp) * 65 + n], tile[(2 * kp + 1) * 65 + n]);
      *(u32*)(dst + (size_t)(n0 + n) * K + k0 + 2 * kp) = v;
    }
  }
  __syncthreads();
}

DI void mod_item(const Params& p, int item, char* smem) {
  const int ke = item & 7, cchunk = (item >> 3) % 48, layer = item / 384;
  const int c0 = cchunk * 64, k0 = ke * 128;
  float* sl = (float*)smem;
  float* red = sl + 5 * 128;
  const int tid = p.tid;
  for (int i = tid; i < 5 * 128; i += 256) {
    const int r = i >> 7, k = k0 + (i & 127);
    const float c = (r == 0) ? p.c_ctx[k] : p.c[(r - 1) * 1024 + k];
    sl[i] = silu(c);
  }
  __syncthreads();
  const int col = tid & 63, kw = tid >> 6;
  float acc[5] = {0.f, 0.f, 0.f, 0.f, 0.f};
  const float* w = p.w_mod + ((size_t)layer * 1024 + k0 + kw * 32) * 3072 + c0 + col;
#pragma unroll
  for (int k = 0; k < 32; ++k) {
    const float wv = __builtin_nontemporal_load(&w[(size_t)k * 3072]);
#pragma unroll
    for (int r = 0; r < 5; ++r) acc[r] += sl[r * 128 + kw * 32 + k] * wv;
  }
#pragma unroll
  for (int r = 0; r < 5; ++r) red[(kw * 5 + r) * 64 + col] = acc[r];
  __syncthreads();
  for (int i = tid; i < 5 * 64; i += 256) {
    const int r = i >> 6, cc = i & 63;
    float s = red[(0 * 5 + r) * 64 + cc] + red[(1 * 5 + r) * 64 + cc] + red[(2 * 5 + r) * 64 + cc] + red[(3 * 5 + r) * 64 + cc];
    if (ke == 0) s += p.b_mod[layer * 3072 + c0 + cc];
    atomicAdd((float*)(p.ws + OFF_MOD) + (layer * 5 + r) * 3072 + c0 + cc, s);
  }
  __syncthreads();
}

DI void phase0(const Params& p, char* smem) {
  char* ws = p.ws;
  const int NTR = 576 + 256 + 832 + 256 + 72 + 64 + 64 + 16;
  for (int item = p.bid; item < NTR + 768; item += gridDim.x) {
    if (item >= NTR) {
      mod_item(p, item - NTR, smem);
      continue;
    }
    int it = item;
    const float* src; const float* g = nullptr; u16* dst; int K, Nsrc, perm, tn;
    if (it < 576) { src = p.w_in_e; dst = (u16*)(ws + OFF_WINE); K = 1024; Nsrc = 2304; perm = 0; tn = 36; }
    else if ((it -= 576) < 256) { src = p.w_out_e; dst = (u16*)(ws + OFF_WOUTE); K = 1024; Nsrc = 1024; perm = 0; tn = 16; }
    else if ((it -= 256) < 832) { src = p.w_in_o; dst = (u16*)(ws + OFF_WINO); K = 1024; Nsrc = 3232; perm = 1; tn = 52; }
    else if ((it -= 832) < 256) { src = p.w_out_o; dst = (u16*)(ws + OFF_WOUTO); K = 1024; Nsrc = 1024; perm = 0; tn = 16; }
    else if ((it -= 256) < 72) { src = p.d_w_uq; g = p.d_q_norm; dst = (u16*)(ws + OFF_WUQ); K = 384; Nsrc = 768; perm = 2; tn = 12; }
    else if ((it -= 72) < 64) { src = p.d_w_ukv; g = p.d_kv_norm; dst = (u16*)(ws + OFF_WUKVG); K = 256; Nsrc = 1024; perm = 3; tn = 16; }
    else if ((it -= 64) < 64) { src = p.d_w_ukv; dst = (u16*)(ws + OFF_WUKV); K = 256; Nsrc = 1024; perm = 3; tn = 16; }
    else { it -= 64; const int gq = it >> 2; it &= 3; src = p.b_map + (size_t)gq * 128 * 128; dst = (u16*)(ws + OFF_WBMAP) + (size_t)gq * 128 * 128; K = 128; Nsrc = 128; perm = 0; tn = 2; }
    transpose_tile(src, g, dst, K, Nsrc, perm, (it / tn) * 64, (it % tn) * 64, smem, p.tid);
  }
  const int gt = p.bid * 256 + p.tid, gs = gridDim.x * 256;
  for (int i = gt; i < 64 * 16 + 64 * 8; i += gs) {
    if (i < 1024) {
      const int pos = i >> 4, f = i & 15;
      const float inv = powf(10000.f, -(float)(2 * f) / 32.f);
      const float ang = (float)pos * inv;
      ((float*)(ws + OFF_ROPEA))[i] = cosf(ang);
      ((float*)(ws + OFF_ROPEA))[1024 + i] = sinf(ang);
    } else {
      const int q = i - 1024, pos = q >> 3, f = q & 7;
      const float inv = powf(10000.f, -(float)(2 * f) / 16.f);
      const float ang = (float)pos * inv;
      ((float*)(ws + OFF_ROPED))[q] = cosf(ang);
      ((float*)(ws + OFF_ROPED))[512 + q] = sinf(ang);
    }
  }
  for (int i = gt; i < 4 * 512 * 128; i += gs) {
    const int b = i >> 16, n = (i >> 7) & 511, cc = i & 127;
    ((u16*)(ws + R_KA))[(size_t)(TP + b * NKS + n) * 128 + cc] = f2bf(p.cache_a_k[i]);
    const int kvh = cc >> 6, d = cc & 63;
    ((u16*)(ws + R_VTAS))[((size_t)(b * 2 + kvh) * 64 + d) * NKS + n] = f2bf(p.cache_a_v[i]);
  }
  for (int i = gt; i < 2048 * 256; i += gs) ((u16*)(ws + OFF_CKVCTX))[i] = f2bf(p.cache_d_ckv[i]);
  for (int i = gt; i < 4 * 512 * 32; i += gs) {
    const int b = i >> 14, n = (i >> 5) & 511, d = i & 31;
    ((u16*)(ws + OFF_KPE))[(size_t)(TP + b * NKS + n) * 32 + d] = f2bf(p.cache_d_kpe[i]);
  }
}

template <int MODE>
DI void norm_phase(const Params& p) {
  const int lane = p.tid & 63, wid = p.tid >> 6;
  const float* mod = (const float*)(p.ws + OFF_MOD);
  u16* H = (u16*)(p.ws + OFF_HU);
  const u16* Y = (const u16*)(p.ws + R_Y);
  constexpr int NR = 2;
  const int stride = gridDim.x * 4;
  f32x4 xv[NR][4], xn[NR][4];
  u32x2 yb[NR][4], yn[NR][4];
#define N_LOAD(XV, YB, R0)                                                                           \
  {                                                                                                  \
    _Pragma("unroll") for (int r = 0; r < NR; ++r) {                                                 \
      const int row = (R0) + r * stride;                                                             \
      if (row < T) {                                                                                 \
        const float* xin = (row < TP) ? p.x_prompt + (size_t)row * 1024 : p.x_sample + (size_t)(row - TP) * 1024; \
        const float* xsrc = (MODE == 2) ? p.out + (size_t)row * 1024 : xin;                          \
        _Pragma("unroll") for (int i = 0; i < 4; ++i) {                                              \
          XV[r][i] = __builtin_nontemporal_load((const f32x4*)(xsrc + lane * 4 + 256 * i));          \
          if (MODE != 0) YB[r][i] = __builtin_nontemporal_load((const u32x2*)(Y + (size_t)row * 1024 + lane * 4 + 256 * i)); \
        }                                                                                            \
      }                                                                                              \
    }                                                                                                \
  }
  f32x4 gpost_r[4], gpre_r[4];
#pragma unroll
  for (int i = 0; i < 4; ++i) {
    const int cc = lane * 4 + 256 * i;
    gpost_r[i] = (MODE != 0) ? *(const f32x4*)(p.g_post + (MODE - 1) * 1024 + cc) : f32x4{0.f, 0.f, 0.f, 0.f};
    gpre_r[i] = (MODE != 2) ? *(const f32x4*)(p.g_pre + ((MODE == 0) ? 0 : 1) * 1024 + cc) : f32x4{0.f, 0.f, 0.f, 0.f};
  }
  int row0 = p.bid * 4 + wid;
  if (row0 < T) N_LOAD(xv, yb, row0);
  for (; row0 < T; row0 += stride * NR) {
    const int rown = row0 + stride * NR;
    if (rown < T) N_LOAD(xn, yn, rown);
    __builtin_amdgcn_sched_barrier(0);
#pragma unroll
    for (int r = 0; r < NR; ++r) {
      const int row = row0 + r * stride;
      if (row >= T) continue;
      const int mrow = (row < TP) ? 0 : 1 + ((row - TP) >> 12);
      float* orow = p.out + (size_t)row * 1024;
      if (MODE != 0) {
        const int L = MODE - 1;
        const float* gate = mod + (L * 5 + mrow) * 3072 + 2048;
        const float* gpost = p.g_post + L * 1024;
        f32x4 yv[4];
        float ss = 0.f;
#pragma unroll
        for (int i = 0; i < 4; ++i) {
          yv[i][0] = bflo(yb[r][i][0]); yv[i][1] = bfhi(yb[r][i][0]); yv[i][2] = bflo(yb[r][i][1]); yv[i][3] = bfhi(yb[r][i][1]);
#pragma unroll
          for (int e = 0; e < 4; ++e) ss += yv[i][e] * yv[i][e];
        }
        ss = wave_sum(ss);
        const float ry = rsqrtf(ss * (1.f / 1024.f) + EPS);
#pragma unroll
        for (int i = 0; i < 4; ++i) {
          const int cc = lane * 4 + 256 * i;
          const f32x4 gt4 = *(const f32x4*)(gate + cc), gp4 = gpost_r[i];
#pragma unroll
          for (int e = 0; e < 4; ++e) xv[r][i][e] = xv[r][i][e] + gt4[e] * (yv[i][e] * ry * gp4[e]);
          __builtin_nontemporal_store(xv[r][i], (f32x4*)(orow + cc));
        }
        if (MODE == 2) continue;
      }
      const int L2 = (MODE == 0) ? 0 : 1;
      const float* shift = mod + (L2 * 5 + mrow) * 3072;
      const float* scale = shift + 1024;
      const float* gpre = p.g_pre + L2 * 1024;
      float ss = 0.f;
#pragma unroll
      for (int i = 0; i < 4; ++i)
#pragma unroll
        for (int e = 0; e < 4; ++e) ss += xv[r][i][e] * xv[r][i][e];
      ss = wave_sum(ss);
      const float rx = rsqrtf(ss * (1.f / 1024.f) + EPS);
#pragma unroll
      for (int i = 0; i < 4; ++i) {
        const int cc = lane * 4 + 256 * i;
        const f32x4 g4 = gpre_r[i], sc4 = *(const f32x4*)(scale + cc), sh4 = *(const f32x4*)(shift + cc);
        float hv[4];
#pragma unroll
        for (int e = 0; e < 4; ++e) hv[e] = xv[r][i][e] * rx * g4[e] * (1.f + sc4[e]) + sh4[e];
        u32x2 o2; o2[0] = pack2(hv[0], hv[1]); o2[1] = pack2(hv[2], hv[3]);
        *(u32x2*)(H + (size_t)row * 1024 + cc) = o2;
      }
    }
#pragma unroll
    for (int r = 0; r < NR; ++r)
#pragma unroll
      for (int i = 0; i < 4; ++i) { xv[r][i] = xn[r][i]; yb[r][i] = yn[r][i]; }
  }
#undef N_LOAD
}

#define GEMM_XCD_LOOP(MT, NT, EPI_)                                                                  \
  {                                                                                                  \
      \
    constexpr int MX_ = (MT) >> 3;                                                                   \
    constexpr int W_ = ((NT) <= 8) ? (NT) : (((NT) % 6 == 0) ? 6 : 7);                               \
    constexpr int NFULL_ = (NT) / W_;                                                                \
    constexpr int NTC_ = (NT);                                                                       \
    const int xcd_ = p.bid & 7, li_ = p.bid >> 3, nb_ = gridDim.x >> 3;                              \
    GemmPre pre_;                                                                                    \
    bool have_ = false;                                                                              \
    int nmt_ = -1, nnt_ = 0;                                                                         \
    for (int idx_ = (p.bid < nb_ * 8) ? li_ : 0x7fffffff; idx_ < MX_ * (NT); idx_ += nb_) {         \
      int mt_, nt_;                                                                                  \
      if (have_) { mt_ = nmt_; nt_ = nnt_; }                                                         \
      else { GEMM_IDX(idx_, mt_, nt_); }                                                             \
      const int nx_ = idx_ + nb_;                                                                    \
      const bool hn_ = nx_ < MX_ * (NT);                                                             \
      if (hn_) { GEMM_IDX(nx_, nmt_, nnt_); }                                                        \
      gemm_tile<EPI_, AL_PLAIN>(p, j, mt_ * 128, nt_ * 128, smem, pre_, have_, hn_ ? nmt_ * 128 : -1, nnt_ * 128); \
      have_ = hn_;                                                                                   \
    }                                                                                                \
  }
#define GEMM_IDX(i_, mo_, no_)                                                                       \
  {                                                                                                  \
    int win_, rem_, wl_;                                                                             \
    if ((i_) < NFULL_ * MX_ * W_) { win_ = (i_) / (MX_ * W_); rem_ = (i_) % (MX_ * W_); wl_ = W_; }  \
    else { win_ = NFULL_; rem_ = (i_) - NFULL_ * MX_ * W_; wl_ = NTC_ - NFULL_ * W_; }               \
    mo_ = (rem_ / wl_) * 8 + xcd_; no_ = win_ * W_ + rem_ % wl_;                                     \
  }
DI void attn_sample_common(AttnJob& j, int idx, int& b, int& qt, int& h) { b = idx >> 8; const int rem = idx & 255; qt = rem >> 3; h = rem & 7; j.qrow0 = TP + b * 4096 + qt * 128; j.qt2 = qt; }
DI void attn_prompt_common(AttnJob& j, int idx, int& b, int& qt, int& h) { b = idx >> 4; const int rem = idx & 15; qt = rem >> 3; h = rem & 7; j.qrow0 = b * 256 + qt * 128; j.qt2 = 0; }

DI void run_phase(const Params& p, int ph, char* smem) {
  char* ws = p.ws;
  if (!((PHMASK >> ph) & 1)) return;
  switch (ph) {
    case 0: phase0(p, smem); break;
    case 1: norm_phase<0>(p); break;
    case 2: {
      GemmJob j; j.A = (const u16*)(ws + OFF_HU); j.lda = 1024; j.Bt = (const u16*)(ws + OFF_WINE); j.K = 1024; j.grp = 0;
      GEMM_XCD_LOOP(192, 18, EPI_EVEN)
    } break;
    case 3: {
      for (int item = p.bid; item < 1024 + 512 + 768; item += gridDim.x) {
        if (item < 1536) {
          AttnJob j; j.tid = p.tid; int b, qt, h;
          const bool samp = item < 1024;
          if (samp) attn_sample_common(j, item, b, qt, h); else attn_prompt_common(j, item - 1024, b, qt, h);
          const int kvh = h >> 2;
          const int krow0 = samp ? TP + b * NKS : b * 256;
          j.Q = (const u16*)(ws + R_QA) + h * 64; j.q_stride = 512;
          j.K = (const u16*)(ws + R_KA) + (size_t)krow0 * 128 + kvh * 64; j.k_stride = 128; j.K2 = nullptr;
          j.nk = samp ? NKS : 256;
          j.Vt = samp ? (const u16*)(ws + R_VTAS) + (size_t)((b * 2 + kvh) * 64) * NKS : (const u16*)(ws + R_VTAP) + (size_t)((b * 2 + kvh) * 64) * 256;
          j.G = (const u16*)(ws + R_GA) + h * 64;
          j.U = (u16*)(ws + OFF_HU) + h * 64;
          j.ntiles = j.nk / 64; j.sc = 0.125f * LOG2E; j.rpb = nullptr;
          attn_item<64, false>(j, smem);
        } else {
          const int q = item - 1536;
          pool_tile(p, (q >> 2) * 128, q & 3, smem);
        }
      }
    } break;
    case 4: {
      GemmJob j; j.A = (const u16*)(ws + OFF_HU); j.lda = 1024; j.Bt = (const u16*)(ws + OFF_WOUTE); j.K = 1024; j.grp = 0;
      GEMM_XCD_LOOP(192, 8, EPI_Y)
    } break;
    case 5: norm_phase<1>(p); break;
    case 6: {
      GemmJob j; j.A = (const u16*)(ws + OFF_HU); j.lda = 1024; j.Bt = (const u16*)(ws + OFF_WINO); j.K = 1024; j.grp = 0;
      {
        const int gt = p.bid * 256 + p.tid, gs = gridDim.x * 256;
        for (int i0 = gt; i0 < 4 * 512 * 512; i0 += gs * 8) {
          float kv[8], vv[8];
#pragma unroll
          for (int u = 0; u < 8; ++u) {
            const int i = i0 + u * gs;
            if (i < 4 * 512 * 512) { kv[u] = __builtin_nontemporal_load(&p.cache_c_k[i]); vv[u] = __builtin_nontemporal_load(&p.cache_c_v[i]); }
          }
#pragma unroll
          for (int u = 0; u < 8; ++u) {
            const int i = i0 + u * gs;
            if (i < 4 * 512 * 512) {
              const int b = i >> 18, n = (i >> 9) & 511, cc = i & 511;
              ((u16*)(ws + R_KC))[(size_t)(TP + b * NKS + n) * 512 + cc] = f2bf(kv[u]);
              const int hh = cc >> 6, d = cc & 63;
              ((u16*)(ws + R_VTCS))[((size_t)(b * 8 + hh) * 64 + d) * NKS + n] = f2bf(vv[u]);
            }
          }
        }
      }
      GEMM_XCD_LOOP(192, 26, EPI_ODD)
    } break;
    case 7: {
      for (int item = p.bid; item < 1536; item += gridDim.x) {
        AttnJob j; j.tid = p.tid; int b, qt, h;
        const bool samp = item < 1024;
        if (samp) attn_sample_common(j, item, b, qt, h); else attn_prompt_common(j, item - 1024, b, qt, h);
        const int krow0 = samp ? TP + b * NKS : b * 256;
        j.Q = (const u16*)(ws + R_QC) + h * 64; j.q_stride = 512;
        j.K = (const u16*)(ws + R_KC) + (size_t)krow0 * 512 + h * 64; j.k_stride = 512; j.K2 = nullptr;
        j.nk = samp ? NKS : 256;
        j.Vt = samp ? (const u16*)(ws + R_VTCS) + (size_t)((b * 8 + h) * 64) * NKS : (const u16*)(ws + R_VTCP) + (size_t)((b * 8 + h) * 64) * 256;
        j.G = (const u16*)(ws + R_GC) + h * 64;
        j.U = (u16*)(ws + OFF_HU) + h * 64;
        j.sc = 0.125f * LOG2E; j.rpb = p.c_rpb + h * 465;
        if (samp) {
          const int r0e = min(max(2 * qt - 4, 0), 56), r0o = min(max(2 * qt - 3, 0), 56);
          j.ntiles = 8 + (r0o + 8 - r0e);
          attn_item<64, true>(j, smem);
        } else {
          j.ntiles = 4;
          attn_item<64, false>(j, smem);
        }
      }
    } break;
    case 8: {
      {
        const int gt = p.bid * 256 + p.tid, gs = gridDim.x * 256;
        const float* ssq = (const float*)(ws + OFF_SSQ);
        for (int i0 = gt; i0 < TP * 64; i0 += gs * 4) {
          f32x4 ov[4], sv[4], gv[4];
#pragma unroll
          for (int u = 0; u < 4; ++u) {
            const int i = i0 + u * gs;
            if (i < TP * 64) {
              ov[u] = *(const f32x4*)(p.out + O_CKV + (size_t)i * 4);
              sv[u] = *(const f32x4*)(ssq + (size_t)(i >> 6) * 16 + 8);
              gv[u] = *(const f32x4*)(p.d_kv_norm + (i & 63) * 4);
            }
          }
#pragma unroll
          for (int u = 0; u < 4; ++u) {
            const int i = i0 + u * gs;
            if (i < TP * 64) {
              const float r = rsqrtf((sv[u][0] + sv[u][1] + sv[u][2] + sv[u][3]) * (1.f / 256.f) + EPS);
              f32x4 o4;
#pragma unroll
              for (int e = 0; e < 4; ++e) o4[e] = ov[u][e] * r * gv[u][e];
              *(f32x4*)(p.out + O_CKV + (size_t)i * 4) = o4;
            }
          }
        }
      }
      {
        const int xcd = p.bid & 7, li = p.bid >> 3, nb = gridDim.x >> 3;
        for (int idx = (p.bid < nb * 8) ? li : 0x7fffffff; idx < 144 + 192 + 16; idx += nb) {
          GemmJob j; j.grp = 0;
          GemmPre pre0;
          if (idx < 144) {
            j.A = (const u16*)(ws + R_CQ); j.lda = 384; j.Bt = (const u16*)(ws + OFF_WUQ); j.K = 384;
            gemm_tile<EPI_Q, AL_PLAIN>(p, j, ((idx / 6) * 8 + xcd) * 128, (idx % 6) * 128, smem, pre0, false, -1, 0);
          } else if (idx < 144 + 192) {
            const int q = idx - 144;
            j.A = (const u16*)(ws + R_CKV); j.lda = 256; j.Bt = (const u16*)(ws + OFF_WUKVG); j.K = 256;
            gemm_tile<EPI_KV, AL_PLAIN>(p, j, ((q >> 3) * 8 + xcd) * 128, (q & 7) * 128, smem, pre0, false, -1, 0);
          } else {
            const int q = idx - 144 - 192;
            j.A = (const u16*)(ws + OFF_CKVCTX); j.lda = 256; j.Bt = (const u16*)(ws + OFF_WUKV); j.K = 256;
            gemm_tile<EPI_KVCTX, AL_PLAIN>(p, j, ((q >> 3) * 8 + xcd) * 128, (q & 7) * 128, smem, pre0, false, -1, 0);
          }
        }
      }
    } break;
    case 9: {
      for (int item = p.bid; item < 1536; item += gridDim.x) {
        AttnJob j; j.tid = p.tid; int b, qt, h;
        const bool samp = item < 1024;
        if (samp) attn_sample_common(j, item, b, qt, h); else attn_prompt_common(j, item - 1024, b, qt, h);
        const int krow0 = samp ? TP + b * NKS : b * 256;
        j.Q = (const u16*)(ws + R_QD) + h * 96; j.q_stride = 768;
        j.K = (const u16*)(ws + R_KD) + (size_t)krow0 * 512 + h * 64; j.k_stride = 512;
        j.K2 = (const u16*)(ws + OFF_KPE) + (size_t)krow0 * 32;
        j.nk = samp ? NKS : 256;
        j.Vt = samp ? (const u16*)(ws + R_VTDS) + (size_t)((b * 8 + h) * 64) * NKS : (const u16*)(ws + R_VTDP) + (size_t)((b * 8 + h) * 64) * 256;
        j.G = (const u16*)(ws + R_GD) + h * 64;
        j.U = (u16*)(ws + OFF_HU) + 512 + h * 64;
        j.ntiles = j.nk / 64; j.sc = 0.10206207261596575f * LOG2E; j.rpb = nullptr;
        attn_item<96, false>(j, smem);
      }
    } break;
    case 10: {
      GemmJob j; j.A = (const u16*)(ws + OFF_HU); j.lda = 1024; j.Bt = (const u16*)(ws + OFF_WOUTO); j.K = 1024; j.grp = 0;
      GEMM_XCD_LOOP(192, 8, EPI_Y)
    } break;
    case 11: norm_phase<2>(p); break;
  }
}

#define XB_TMO      128
#define XB_XCNT(j)  (256  + 64 * (j))
#define XB_XSUB(j)  (1280 + 64 * (j))
#define XB_XGEN(j)  (2304 + 64 * (j))
#define XB_TOP      3328
#define XB_TOPGEN   3392
#define XCD_BAR_WORDS 3456
#define XB_SPIN_CAP (1u << 18)
#define LAS __attribute__((address_space(3)))

__device__ __forceinline__ unsigned xb_ld(unsigned* p)              { return __hip_atomic_load(p, __ATOMIC_RELAXED, __HIP_MEMORY_SCOPE_AGENT); }
__device__ __forceinline__ unsigned xb_add(unsigned* p, unsigned v) { return __hip_atomic_fetch_add(p, v, __ATOMIC_RELAXED, __HIP_MEMORY_SCOPE_AGENT); }
__device__ __forceinline__ unsigned xb_xcc_id() { return (unsigned)__builtin_amdgcn_s_getreg((3 << 11) | 20) & 0xFu; }
#define XB_SPIN(cond, bar) do { unsigned _sp = 0; while (cond) { __builtin_amdgcn_s_sleep(1); \
    if ((++_sp & 255u) == 0u) { if (xb_ld(&(bar)[XB_TMO])) break; if (_sp > XB_SPIN_CAP) { atomicAdd(&(bar)[XB_TMO], 1u); break; } } } } while (0)

struct XcdBarrier {
    unsigned* bar; unsigned x;
    volatile LAS unsigned* st;
};

__device__ __forceinline__ XcdBarrier xcd_barrier_post(unsigned* bar, volatile LAS unsigned* st) {
    XcdBarrier b; b.bar = bar; b.x = xb_xcc_id(); b.st = st;
    if (threadIdx.x == 0) (void)xb_add(&bar[XB_XCNT(b.x)], 1u);
    return b;
}
__device__ __forceinline__ void xcd_barrier_complete(unsigned* bar, unsigned x, unsigned& nloc, unsigned& nx) {
    const unsigned G = gridDim.x * gridDim.y * gridDim.z;
    unsigned sum, cnt, mine, sp = 0u;
    for (;;) {
        sum = 0u; cnt = 0u; mine = 0u;
#pragma unroll
        for (unsigned j = 0; j < 16; ++j) { const unsigned c = xb_ld(&bar[XB_XCNT(j)]); sum += c; cnt += (c > 0u) ? 1u : 0u; mine = (j == x) ? c : mine; }
        if (sum == G) break;
        __builtin_amdgcn_s_sleep(1);
        if ((++sp & 255u) == 0u) { if (xb_ld(&bar[XB_TMO])) break; if (sp > XB_SPIN_CAP) { atomicAdd(&bar[XB_TMO], 1u); break; } }
    }
    nloc = mine > 0u ? mine : 1u; nx = cnt > 0u ? cnt : 1u;
}

__device__ __forceinline__ void xcd_barrier(const XcdBarrier& b) {
    asm volatile("s_waitcnt vmcnt(0)" ::: "memory");
    __syncthreads();
    if (threadIdx.x == 0) {
        unsigned* bar = b.bar;
        __builtin_amdgcn_s_waitcnt(0);
        unsigned nloc = b.st[0], nx = b.st[1];
        if (nloc == 0u) { xcd_barrier_complete(bar, b.x, nloc, nx); b.st[0] = nloc; b.st[1] = nx; }
        const unsigned old = xb_add(&bar[XB_XSUB(b.x)], 1u);
        const unsigned gen = old / nloc;
        if (old + 1u == (gen + 1u) * nloc) {
            __builtin_amdgcn_fence(__ATOMIC_RELEASE, "agent");
            asm volatile("s_waitcnt vmcnt(0)" ::: "memory");
            const unsigned og = xb_add(&bar[XB_TOP], 1u);
            const unsigned tg = og / nx;
            if (og + 1u == (tg + 1u) * nx) xb_add(&bar[XB_TOPGEN], 1u);
            else XB_SPIN(xb_ld(&bar[XB_TOPGEN]) == tg, bar);
            __builtin_amdgcn_fence(__ATOMIC_ACQUIRE, "agent");
            xb_add(&bar[XB_XGEN(b.x)], 1u);
            asm volatile("s_waitcnt vmcnt(0)" ::: "memory");
        } else {
            XB_SPIN(xb_ld(&bar[XB_XGEN(b.x)]) == gen, bar);
            __builtin_amdgcn_fence(__ATOMIC_ACQUIRE, "agent");
            asm volatile("s_waitcnt vmcnt(0)" ::: "memory");
        }
    }
    __syncthreads();
}


__global__ void __launch_bounds__(256, 2) mega(Params p0, int ph_lo, int ph_hi) {
  __shared__ __attribute__((aligned(16))) char smem[SMEM_BYTES];
  __shared__ uint4 xb_words;
  if (threadIdx.x == 0) xb_words = make_uint4(0u, 0u, 0u, 0u);
  __syncthreads();
  XcdBarrier xb = xcd_barrier_post((unsigned*)(p0.ws + OFF_BAR), (volatile LAS unsigned*)&xb_words);
  int ph_rep = 0;
  for (int ph = ph_lo; ph < ph_hi; ++ph) {
    Params p = p0;
#define GP(f) p.f = (const float*)(const GLOBAL float*)p0.f;
    GP(x_prompt) GP(x_sample) GP(cache_a_k) GP(cache_a_v) GP(cache_c_k) GP(cache_c_v) GP(cache_d_ckv) GP(cache_d_kpe)
    GP(c) GP(c_ctx) GP(w_mod) GP(b_mod) GP(g_pre) GP(g_post) GP(w_in_e) GP(a_q_norm) GP(a_k_norm) GP(b_map) GP(b_scale) GP(w_out_e)
    GP(w_in_o) GP(c_rpb) GP(d_q_norm) GP(d_w_uq) GP(d_kv_norm) GP(d_w_ukv) GP(w_out_o)
#undef GP
    int tid = threadIdx.x, bid = blockIdx.x;
    GLOBAL char* ws = (GLOBAL char*)p0.ws; GLOBAL float* out = (GLOBAL float*)p0.out;
    asm volatile("" : "+v"(tid));
    asm volatile("" : "+s"(bid));
    asm volatile("" : "+s"(ws));
    asm volatile("" : "+s"(out));
    p.tid = tid; p.bid = bid; p.ws = (char*)ws; p.out = (float*)out;
#if REPEAT_MASK
    if ((REPEAT_MASK >> ph) & 1) ph_rep ^= 1;
#endif
    run_phase(p, ph, smem);
#if REPEAT_MASK
    if (ph_rep) { --ph; xcd_barrier(xb); continue; }
#endif
    if (ph + 1 < ph_hi) xcd_barrier(xb);
    if (ph_hi < 0) cg::this_grid().sync();
  }
}

extern "C" void kernel_launch(void* const* d_in, const int* in_sizes, int n_in, void* d_out, int out_size, void* d_ws, size_t ws_size, hipStream_t stream) {
  static int grid = 0;
  if (!grid) {
    int dev = 0, cus = 0, per_cu = 0;
    hipGetDevice(&dev);
    hipDeviceGetAttribute(&cus, hipDeviceAttributeMultiprocessorCount, dev);
    hipOccupancyMaxActiveBlocksPerMultiprocessor(&per_cu, mega, 256, 0);
    if (per_cu < 1) per_cu = 1;
    if (per_cu > 2) per_cu = 2;
    grid = cus * per_cu;
    if (ws_size < WS_LIMIT + 16384) fprintf(stderr, "kernel_launch: ws too small (%zu)\n", ws_size);
  }
  Params p{};
  const float** pp = (const float**)&p;
  for (int i = 0; i < 27; ++i) pp[i] = (const float*)d_in[i];
  p.out = (float*)d_out;
  p.ws = (char*)d_ws;
#if MK_COOP
  hipMemsetAsync((char*)d_ws + OFF_MOD, 0, 2 * 5 * 3072 * 4 + XCD_BAR_WORDS * 4, stream);
  int lo = 0, hi = NPHASE;
  void* args[] = {&p, &lo, &hi};
  hipError_t e = hipLaunchCooperativeKernel((void*)mega, dim3(grid), dim3(256), args, 0, stream);
  if (e != hipSuccess) fprintf(stderr, "cooperative launch failed: %s (grid %d)\n", hipGetErrorString(e), grid);
#else
  for (int ph = 0; ph < NPHASE; ++ph) hipLaunchKernelGGL(mega, dim3(grid), dim3(256), 0, stream, p, ph, ph + 1);
#endif
}
```

```cpp
#include <hip/hip_runtime.h>
#include <hip/hip_cooperative_groups.h>
#include <cstdio>
namespace cg = cooperative_groups;

#ifndef PHMASK
#define PHMASK 0xFFF
#endif
#ifndef REPEAT_MASK
#define REPEAT_MASK 0
#endif
#ifndef MK_COOP
#define MK_COOP 1
#endif

#define DI __device__ __forceinline__
#define GLOBAL __attribute__((address_space(1)))
typedef unsigned short u16;
typedef unsigned int u32;
typedef __attribute__((ext_vector_type(8))) short bf16x8;
typedef __attribute__((ext_vector_type(4))) short s16x4;
typedef __attribute__((ext_vector_type(16))) float f32x16;
typedef __attribute__((ext_vector_type(4))) float f32x4;
typedef __attribute__((ext_vector_type(2))) float f32x2;
typedef __attribute__((ext_vector_type(4))) u32 u32x4;
typedef __attribute__((ext_vector_type(2))) u32 u32x2;

constexpr int TP = 8192, TS = 16384, T = 24576, NKS = 4608, KROWS = 26624;
constexpr float EPS = 1e-6f;
constexpr float LOG2E = 1.4426950408889634f;
constexpr int NPHASE = 12;
constexpr int SMEM_BYTES = 73728;

constexpr size_t OFF_WINE = 0;
constexpr size_t OFF_WOUTE = OFF_WINE + 2304ull * 1024 * 2;
constexpr size_t OFF_WINO = OFF_WOUTE + 1024ull * 1024 * 2;
constexpr size_t OFF_WOUTO = OFF_WINO + 3328ull * 1024 * 2;
constexpr size_t OFF_WUQ = OFF_WOUTO + 1024ull * 1024 * 2;
constexpr size_t OFF_WUKVG = OFF_WUQ + 768ull * 384 * 2;
constexpr size_t OFF_WUKV = OFF_WUKVG + 1024ull * 256 * 2;
constexpr size_t OFF_WBMAP = OFF_WUKV + 1024ull * 256 * 2;
constexpr size_t OFF_MOD = OFF_WBMAP + 4ull * 128 * 128 * 2;
constexpr size_t OFF_BAR = OFF_MOD + 2ull * 5 * 3072 * 4;
constexpr size_t OFF_ROPEA = OFF_BAR + 16384;
constexpr size_t OFF_ROPED = OFF_ROPEA + 2ull * 64 * 16 * 4;
constexpr size_t OFF_CKVCTX = OFF_ROPED + 2ull * 64 * 8 * 4;
constexpr size_t OFF_KPE = OFF_CKVCTX + 2048ull * 256 * 2;
constexpr size_t OFF_SSQ = OFF_KPE + 26624ull * 32 * 2;
constexpr size_t OFF_HU = OFF_SSQ + 24576ull * 16 * 4;
constexpr size_t OFF_R = OFF_HU + 24576ull * 1024 * 2;
constexpr size_t R_QA = OFF_R;
constexpr size_t R_GA = R_QA + (size_t)T * 512 * 2;
constexpr size_t R_GB = R_GA + (size_t)T * 512 * 2;
constexpr size_t R_UB = R_GB + (size_t)T * 512 * 2;
constexpr size_t R_KA = R_UB + (size_t)T * 512 * 2;
constexpr size_t R_VTAP = R_KA + (size_t)KROWS * 128 * 2;
constexpr size_t R_VTAS = R_VTAP + 32ull * 2 * 64 * 256 * 2;
constexpr size_t R_L0END = R_VTAS + 4ull * 2 * 64 * NKS * 2;
constexpr size_t R_Y = OFF_R;
constexpr size_t R_GD = OFF_R;
constexpr size_t R_CQ = R_GD + (size_t)T * 512 * 2;
constexpr size_t R_CKV = R_CQ + (size_t)T * 384 * 2;
constexpr size_t R_Z = R_CKV + (size_t)T * 256 * 2;
constexpr size_t R_QC = R_Z;
constexpr size_t R_GC = R_QC + (size_t)T * 512 * 2;
constexpr size_t R_KC = R_GC + (size_t)T * 512 * 2;
constexpr size_t R_VTCP = R_KC + (size_t)KROWS * 512 * 2;
constexpr size_t R_VTCS = R_VTCP + 32ull * 8 * 64 * 256 * 2;
constexpr size_t R_L1END_A = R_VTCS + 4ull * 8 * 64 * NKS * 2;
constexpr size_t R_QD = R_Z;
constexpr size_t R_KD = R_QD + (size_t)T * 768 * 2;
constexpr size_t R_VTDP = R_KD + (size_t)KROWS * 512 * 2;
constexpr size_t R_VTDS = R_VTDP + 32ull * 8 * 64 * 256 * 2;
constexpr size_t R_L1END_B = R_VTDS + 4ull * 8 * 64 * NKS * 2;
constexpr size_t WS_LIMIT = 256ull * 1024 * 1024 - 16384;
static_assert(R_L0END <= WS_LIMIT && R_L1END_A <= WS_LIMIT && R_L1END_B <= WS_LIMIT, "ws overflow");
static_assert(R_Y + (size_t)T * 1024 * 4 <= R_KA, "y aliasing");
static_assert(R_Y + (size_t)T * 1024 * 4 <= WS_LIMIT, "y fits");

constexpr size_t O_Y = 0;
constexpr size_t O_AK = 25165824;
constexpr size_t O_AV = O_AK + 1048576;
constexpr size_t O_CK = O_AV + 1048576;
constexpr size_t O_CV = O_CK + 4194304;
constexpr size_t O_CKV = O_CV + 4194304;
constexpr size_t O_KPE = O_CKV + 2097152;

struct Params {
  const float *x_prompt, *x_sample, *cache_a_k, *cache_a_v, *cache_c_k, *cache_c_v, *cache_d_ckv, *cache_d_kpe;
  const float *c, *c_ctx, *w_mod, *b_mod, *g_pre, *g_post, *w_in_e, *a_q_norm, *a_k_norm, *b_map, *b_scale, *w_out_e;
  const float *w_in_o, *c_rpb, *d_q_norm, *d_w_uq, *d_kv_norm, *d_w_ukv, *w_out_o;
  float* out;
  char* ws;
  int tid, bid;
};

DI u32 pack2(float a, float b) {
  typedef __attribute__((ext_vector_type(2))) __bf16 bf2;
  bf2 v;
  v[0] = (__bf16)a;
  v[1] = (__bf16)b;
  return __builtin_bit_cast(u32, v);
}
DI u16 f2bf(float a) { return __builtin_bit_cast(u16, (__bf16)a); }
DI float bf2f(u16 u) { return __uint_as_float(((u32)u) << 16); }
DI float bflo(u32 u) { return __uint_as_float(u << 16); }
DI float bfhi(u32 u) { return __uint_as_float(u & 0xffff0000u); }
DI float silu(float x) { return x * __builtin_amdgcn_rcpf(1.f + __builtin_amdgcn_exp2f(-1.4426950408889634f * x)); }
DI f32x16 mfma32(bf16x8 a, bf16x8 b, f32x16 c) { return __builtin_amdgcn_mfma_f32_32x32x16_bf16(a, b, c, 0, 0, 0); }
DI void unpack8(u32x4 u, float* f) {
  f[0] = bflo(u[0]); f[1] = bfhi(u[0]); f[2] = bflo(u[1]); f[3] = bfhi(u[1]);
  f[4] = bflo(u[2]); f[5] = bfhi(u[2]); f[6] = bflo(u[3]); f[7] = bfhi(u[3]);
}
DI u32x4 pack8(const float* f) {
  u32x4 u;
  u[0] = pack2(f[0], f[1]); u[1] = pack2(f[2], f[3]); u[2] = pack2(f[4], f[5]); u[3] = pack2(f[6], f[7]);
  return u;
}
DI void ld8(const float* p, float* v) {
  const f32x4 a = *(const f32x4*)p, b = *(const f32x4*)(p + 4);
  v[0] = a[0]; v[1] = a[1]; v[2] = a[2]; v[3] = a[3]; v[4] = b[0]; v[5] = b[1]; v[6] = b[2]; v[7] = b[3];
}
DI void st8(float* p, const float* v) {
  f32x4 a, b;
  a[0] = v[0]; a[1] = v[1]; a[2] = v[2]; a[3] = v[3]; b[0] = v[4]; b[1] = v[5]; b[2] = v[6]; b[3] = v[7];
  *(f32x4*)p = a; *(f32x4*)(p + 4) = b;
}
DI float xhalf_max(float x) {
  const auto r = __builtin_amdgcn_permlane32_swap(__float_as_uint(x), __float_as_uint(x), false, false);
  return fmaxf(__uint_as_float(r[0]), __uint_as_float(r[1]));
}
DI float xhalf_sum(float x) {
  const auto r = __builtin_amdgcn_permlane32_swap(__float_as_uint(x), __float_as_uint(x), false, false);
  return __uint_as_float(r[0]) + __uint_as_float(r[1]);
}
DI float red8(float v) {
  v += __shfl_xor(v, 1);
  v += __shfl_xor(v, 2);
  v += __shfl_xor(v, 4);
  return v;
}
DI float wave_sum(float v) {
  v += __shfl_xor(v, 1); v += __shfl_xor(v, 2); v += __shfl_xor(v, 4);
  v += __shfl_xor(v, 8); v += __shfl_xor(v, 16); v += __shfl_xor(v, 32);
  return v;
}

struct RowInfo { int samp, b, t, krow, key, nk, mrow; };
DI RowInfo row_info(int row) {
  RowInfo r;
  if (row < TP) { r.samp = 0; r.b = row >> 8; r.t = row & 255; r.krow = row; r.key = r.t; r.nk = 256; r.mrow = 0; }
  else { int q = row - TP; r.samp = 1; r.b = q >> 12; r.t = q & 4095; r.krow = TP + r.b * NKS + 512 + r.t; r.key = 512 + r.t; r.nk = NKS; r.mrow = 1 + r.b; }
  return r;
}

enum { EPI_EVEN = 0, EPI_Y = 1, EPI_ODD = 2, EPI_Q = 3, EPI_KV = 4, EPI_KVCTX = 5, EPI_POOL = 6 };
enum { AL_PLAIN = 0, AL_POOL = 1 };
constexpr int LROW = 144;
constexpr int TILEB = 128 * LROW;
constexpr int CSTR = 132;

struct GemmJob {
  const u16* A; int lda;
  const u16* Bt;
  int K;
  int grp;
};

template <int ALOAD>
DI u32x4 load_a_chunk(const GemmJob& j, int grow, int kofs) {
  if (ALOAD == AL_PLAIN) {
    return *(const u32x4*)(j.A + (size_t)grow * j.lda + kofs);
  } else {
    const int g = j.grp;
    const int w2 = 1 << g;
    int t, S;
    if (grow < TP) { t = grow & 255; S = 256; } else { t = (grow - TP) & 4095; S = 4096; }
    const int lo = max(t - w2, 0), hi = min(t + w2, S);
    const u16* base = j.A + (size_t)(grow - t) * 512 + g * 128 + kofs;
    float s[8];
#pragma unroll
    for (int e = 0; e < 8; ++e) s[e] = 0.f;
    for (int r = lo; r < hi; ++r) {
      u32x4 u = *(const u32x4*)(base + (size_t)r * 512);
      float f[8]; unpack8(u, f);
#pragma unroll
      for (int e = 0; e < 8; ++e) s[e] += f[e];
    }
    u32x4 u = *(const u32x4*)(base + (size_t)t * 512);
    float f[8]; unpack8(u, f);
    const float inv = 1.f / (float)(hi - lo);
#pragma unroll
    for (int e = 0; e < 8; ++e) s[e] = s[e] * inv - f[e];
    return pack8(s);
  }
}

template <int EPI>
DI void gemm_epilogue(const Params& p, const GemmJob& j, int m0, int n0, const float* Cs, int tid);

struct GemmPre { u32x4 ra[4], rb[4]; };
template <int EPI, int ALOAD>
DI void gemm_tile(const Params& p, const GemmJob& j, int m0, int n0, char* smem, GemmPre& pre, bool have_pre, int nm0, int nn0) {
  const int tid = p.tid, lane = tid & 63, wid = tid >> 6;
  const int wm = wid >> 1, wn = wid & 1, l31 = lane & 31, lh = lane >> 5;
  f32x16 acc[2][2];
#pragma unroll
  for (int a = 0; a < 2; ++a)
#pragma unroll
    for (int b = 0; b < 2; ++b)
#pragma unroll
      for (int i = 0; i < 16; ++i) acc[a][b][i] = 0.f;
  const int nk = j.K >> 6;
  u32x4 ra[4], rb[4];
#define G_LOAD_T(RA, RB, mm, nn, kt)                                                                 \
  {                                                                                                  \
    _Pragma("unroll") for (int i = 0; i < 4; ++i) {                                                  \
      const int row = tid >> 1, kc = (tid & 1) * 4 + i;                                              \
      RA[i] = load_a_chunk<ALOAD>(j, (mm) + row, (kt) * 64 + kc * 8);                                \
      RB[i] = *(const u32x4*)(j.Bt + (size_t)((nn) + row) * j.K + (kt) * 64 + kc * 8);               \
    }                                                                                                \
  }
#define G_LOAD(kt) G_LOAD_T(ra, rb, m0, n0, kt)
#define G_STORE(st)                                                                                  \
  {                                                                                                  \
    char* sa = smem + (st) * 2 * TILEB;                                                              \
    char* sb = sa + TILEB;                                                                           \
    _Pragma("unroll") for (int i = 0; i < 4; ++i) {                                                  \
      const int row = tid >> 1, kc = (tid & 1) * 4 + i;                                              \
      *(u32x4*)(sa + row * LROW + kc * 16) = ra[i];                                                  \
      *(u32x4*)(sb + row * LROW + kc * 16) = rb[i];                                                  \
    }                                                                                                \
  }
  if (have_pre) {
#pragma unroll
    for (int i = 0; i < 4; ++i) { ra[i] = pre.ra[i]; rb[i] = pre.rb[i]; }
  } else {
    G_LOAD(0);
  }
  G_STORE(0);
  if (nk > 1) G_LOAD(1);
  __syncthreads();
  for (int kt = 0; kt < nk; ++kt) {
    __builtin_amdgcn_sched_barrier(0);
    const char* sa = smem + (kt & 1) * 2 * TILEB;
    const char* sb = sa + TILEB;
    bf16x8 af[2][2], bfr[2][2];
#define LDFRAG(buf, kk)                                                                              \
  {                                                                                                  \
    _Pragma("unroll") for (int mt = 0; mt < 2; ++mt) af[buf][mt] = *(const bf16x8*)(sa + (wm * 64 + mt * 32 + l31) * LROW + (kk) * 32 + lh * 16); \
    _Pragma("unroll") for (int nt = 0; nt < 2; ++nt) bfr[buf][nt] = *(const bf16x8*)(sb + (wn * 64 + nt * 32 + l31) * LROW + (kk) * 32 + lh * 16); \
  }
    LDFRAG(0, 0);
#pragma unroll
    for (int kk = 0; kk < 4; ++kk) {
      if (kk < 3) LDFRAG((kk + 1) & 1, kk + 1);
      __builtin_amdgcn_sched_barrier(0);
#pragma unroll
      for (int mt = 0; mt < 2; ++mt)
#pragma unroll
        for (int nt = 0; nt < 2; ++nt) acc[mt][nt] = mfma32(af[kk & 1][mt], bfr[kk & 1][nt], acc[mt][nt]);
      __builtin_amdgcn_sched_barrier(0);
    }
#undef LDFRAG
    __builtin_amdgcn_sched_barrier(0);
    if (kt + 1 < nk) {
      G_STORE((kt + 1) & 1);
      if (kt + 2 < nk) G_LOAD(kt + 2);
    }
    __builtin_amdgcn_sched_barrier(0);
    __syncthreads();
  }
#undef G_STORE
  float* Cs = (float*)smem;
#pragma unroll
  for (int mt = 0; mt < 2; ++mt)
#pragma unroll
    for (int nt = 0; nt < 2; ++nt)
#pragma unroll
      for (int i = 0; i < 16; ++i) {
        const int row = wm * 64 + mt * 32 + (i & 3) + 8 * (i >> 2) + 4 * lh;
        const int col = wn * 64 + nt * 32 + l31;
        Cs[row * CSTR + col] = acc[mt][nt][i];
      }
  __syncthreads();
  if (nm0 >= 0) G_LOAD_T(pre.ra, pre.rb, nm0, nn0, 0);
  __builtin_amdgcn_sched_barrier(0);
  gemm_epilogue<EPI>(p, j, m0, n0, Cs, tid);
  __syncthreads();
#undef G_LOAD
#undef G_LOAD_T
}

DI void pool_tile(const Params& p, int m0, int g, char* smem) {
  const int tid = p.tid, lane = tid & 63, wid = tid >> 6;
  const int wm = wid >> 1, wn = wid & 1, l31 = lane & 31, lh = lane >> 5;
  const u16* Ub = (const u16*)(p.ws + R_UB);
  const u16* Bt = (const u16*)(p.ws + OFF_WBMAP) + (size_t)g * 128 * 128;
  const int w2 = 1 << g;
  const int row = tid >> 1, kcb = (tid & 1) * 4;
#pragma unroll
  for (int kt = 0; kt < 2; ++kt)
#pragma unroll
    for (int i = 0; i < 4; ++i)
      *(u32x4*)(smem + kt * 2 * TILEB + TILEB + row * LROW + (kcb + i) * 16) = *(const u32x4*)(Bt + (size_t)row * 128 + kt * 64 + (kcb + i) * 8);
  {
    const int grow = m0 + row;
    int t, S;
    if (grow < TP) { t = grow & 255; S = 256; } else { t = (grow - TP) & 4095; S = 4096; }
    const float inv = 1.f / (float)(min(t + w2, S) - max(t - w2, 0));
#pragma unroll 1
    for (int q = 0; q < 8; ++q) {
      const int kt = q >> 2, kc = kcb + (q & 3);
      const u16* base = Ub + (size_t)(grow - t) * 512 + g * 128 + kt * 64 + kc * 8;
      u32x4 u[16];
#pragma unroll
      for (int r = 0; r < 16; ++r)
        if (r < 2 * w2) {
          const int rc = min(max(t - w2 + r, 0), S - 1);
          u[r] = *(const u32x4*)(base + (size_t)rc * 512);
        }
      const u32x4 uo = *(const u32x4*)(base + (size_t)t * 512);
      float sacc[8];
#pragma unroll
      for (int e = 0; e < 8; ++e) sacc[e] = 0.f;
#pragma unroll
      for (int r = 0; r < 16; ++r)
        if (r < 2 * w2) {
          const int rr = t - w2 + r;
          const float ok = (rr >= 0 && rr < S) ? 1.f : 0.f;
          float x[8]; unpack8(u[r], x);
#pragma unroll
          for (int e = 0; e < 8; ++e) sacc[e] += ok * x[e];
        }
      float f[8]; unpack8(uo, f);
#pragma unroll
      for (int e = 0; e < 8; ++e) sacc[e] = sacc[e] * inv - f[e];
      *(u32x4*)(smem + kt * 2 * TILEB + row * LROW + kc * 16) = pack8(sacc);
    }
  }
  __syncthreads();
  f32x16 acc[2][2];
#pragma unroll
  for (int a = 0; a < 2; ++a)
#pragma unroll
    for (int b = 0; b < 2; ++b)
#pragma unroll
      for (int i = 0; i < 16; ++i) acc[a][b][i] = 0.f;
#pragma unroll
  for (int kt = 0; kt < 2; ++kt) {
    const char* sa = smem + kt * 2 * TILEB;
    const char* sb = sa + TILEB;
#pragma unroll
    for (int kk = 0; kk < 4; ++kk) {
      bf16x8 af[2], bfr[2];
#pragma unroll
      for (int mt = 0; mt < 2; ++mt) af[mt] = *(const bf16x8*)(sa + (wm * 64 + mt * 32 + l31) * LROW + kk * 32 + lh * 16);
#pragma unroll
      for (int nt = 0; nt < 2; ++nt) bfr[nt] = *(const bf16x8*)(sb + (wn * 64 + nt * 32 + l31) * LROW + kk * 32 + lh * 16);
#pragma unroll
      for (int mt = 0; mt < 2; ++mt)
#pragma unroll
        for (int nt = 0; nt < 2; ++nt) acc[mt][nt] = mfma32(af[mt], bfr[nt], acc[mt][nt]);
    }
  }
  __syncthreads();
  float* Cs = (float*)smem;
#pragma unroll
  for (int mt = 0; mt < 2; ++mt)
#pragma unroll
    for (int nt = 0; nt < 2; ++nt)
#pragma unroll
      for (int i = 0; i < 16; ++i) {
        const int r2 = wm * 64 + mt * 32 + (i & 3) + 8 * (i >> 2) + 4 * lh;
        const int c2 = wn * 64 + nt * 32 + l31;
        Cs[r2 * CSTR + c2] = acc[mt][nt][i];
      }
  __syncthreads();
  GemmJob j; j.A = nullptr; j.lda = 0; j.Bt = nullptr; j.K = 128; j.grp = g;
  gemm_epilogue<EPI_POOL>(p, j, m0, 0, Cs, tid);
  __syncthreads();
}

DI void store_vt_tile(const float* Cs, int m0, int tid, u16* vtP, u16* vtS, int nheads, int head0, const float* rowscale_ssq, int ssq_ofs, int ssq_n, float ssq_div, bool ctx_rows) {
  const int r = tid & 127, half = tid >> 7;
  int b, key, nk; u16* base;
  if (ctx_rows) {
    const int i = m0 + r; b = i >> 9; key = i & 511; nk = NKS; base = vtS;
  } else {
    RowInfo ri = row_info(m0 + r); b = ri.b; key = ri.key; nk = ri.nk; base = ri.samp ? vtS : vtP;
  }
  float rs = 1.f;
  if (rowscale_ssq) {
    float s = 0.f;
    for (int q = 0; q < ssq_n; ++q) s += rowscale_ssq[(size_t)(m0 + r) * 16 + ssq_ofs + q];
    rs = rsqrtf(s / ssq_div + EPS);
  }
  const int head = head0 + half;
  u16* dst = base + ((size_t)(b * nheads + head) * 64) * nk + key;
#pragma unroll 4
  for (int j4 = 0; j4 < 16; ++j4) {
    f32x4 f = *(const f32x4*)(Cs + r * CSTR + half * 64 + j4 * 4);
#pragma unroll
    for (int e = 0; e < 4; ++e) dst[(size_t)(j4 * 4 + e) * nk] = f2bf(f[e] * rs);
  }
}

template <int EPI>
DI void gemm_epilogue(const Params& p, const GemmJob& j, int m0, int n0, const float* Cs, int tid) {
  char* ws = p.ws;
  const int ntile = n0 >> 7;
  if (EPI == EPI_Y) {
    u16* y = (u16*)(ws + R_Y);
#pragma unroll
    for (int it = 0; it < 8; ++it) {
      const int item = it * 256 + tid, row = item >> 4, col0 = (item & 15) * 8;
      float v[8];
      ld8(Cs + row * CSTR + col0, v);
      *(u32x4*)(y + (size_t)(m0 + row) * 1024 + n0 + col0) = pack8(v);
    }
    return;
  }
  if (EPI == EPI_POOL) {
    const int g = j.grp;
    const u16* Gb = (const u16*)(ws + R_GB);
    u16* U = (u16*)(ws + OFF_HU);
#pragma unroll
    for (int it = 0; it < 8; ++it) {
      const int item = it * 256 + tid, row = item >> 4, col0 = (item & 15) * 8;
      const int grow = m0 + row, gc = g * 128 + col0;
      float v[8], gt[8];
      ld8(Cs + row * CSTR + col0, v);
      unpack8(*(const u32x4*)(Gb + (size_t)grow * 512 + gc), gt);
#pragma unroll
      for (int e = 0; e < 8; ++e) v[e] = v[e] * p.b_scale[gc + e] * gt[e];
      *(u32x4*)(U + (size_t)grow * 1024 + 512 + gc) = pack8(v);
    }
    return;
  }
  if (EPI == EPI_EVEN) {
    if (ntile == 5) {
#pragma unroll
      for (int it = 0; it < 8; ++it) {
        const int item = it * 256 + tid, row = item >> 4, col0 = (item & 15) * 8;
        const int grow = m0 + row;
        if (grow < TP) {
          float* d = p.out + O_AV + (size_t)grow * 128 + col0;
          *(f32x4*)d = *(const f32x4*)(Cs + row * CSTR + col0); *(f32x4*)(d + 4) = *(const f32x4*)(Cs + row * CSTR + col0 + 4);
        }
      }
      store_vt_tile(Cs, m0, tid, (u16*)(ws + R_VTAP), (u16*)(ws + R_VTAS), 2, 0, nullptr, 0, 0, 1.f, false);
      return;
    }
    const float* ropec = (const float*)(ws + OFF_ROPEA);
    const float* ropes = ropec + 64 * 16;
    float gnv[8], gpv[8];
    {
      const float* gn0 = (ntile < 4) ? p.a_q_norm : p.a_k_norm;
      const int d0c = (n0 + (tid & 15) * 8) & 63;
#pragma unroll
      for (int e = 0; e < 8; ++e) { gnv[e] = (ntile <= 4) ? gn0[d0c + e] : 0.f; gpv[e] = (ntile <= 4) ? gn0[(d0c ^ 16) + e] : 0.f; }
    }
#pragma unroll
    for (int it = 0; it < 8; ++it) {
      const int item = it * 256 + tid, row = item >> 4, col0 = (item & 15) * 8;
      const int grow = m0 + row, gcol = n0 + col0;
      float v[8];
      ld8(Cs + row * CSTR + col0, v);
      if (ntile <= 4) {
        const bool isq = ntile < 4;
        const RowInfo ri = row_info(grow);
        const int d0 = gcol & 63;
        float ss = 0.f;
#pragma unroll
        for (int e = 0; e < 8; ++e) ss += v[e] * v[e];
        ss = red8(ss);
        const float r = rsqrtf(ss * (1.f / 64.f) + EPS);
        float nv[8];
#pragma unroll
        for (int e = 0; e < 8; ++e) nv[e] = v[e] * r * gnv[e];
        if (!isq && !ri.samp) {
          float* d = p.out + O_AK + (size_t)grow * 128 + (gcol - 512);
          st8(d, nv);
        }
        if (ri.samp) {
          const int pc = col0 ^ 16, pd0 = d0 ^ 16;
          float pv[8];
          ld8(Cs + row * CSTR + pc, pv);
          const int pos = (d0 < 32) ? (ri.t >> 6) : (ri.t & 63);
          const int i0 = d0 & 15;
          const float sgn = (d0 & 16) ? 1.f : -1.f;
#pragma unroll
          for (int e = 0; e < 8; ++e) {
            const float pn = pv[e] * r * gpv[e];
            const float cs = ropec[pos * 16 + i0 + e], sn = ropes[pos * 16 + i0 + e];
            nv[e] = nv[e] * cs + sgn * pn * sn;
          }
        }
        if (isq) *(u32x4*)((u16*)(ws + R_QA) + (size_t)grow * 512 + gcol) = pack8(nv);
        else *(u32x4*)((u16*)(ws + R_KA) + (size_t)ri.krow * 128 + (gcol - 512)) = pack8(nv);
      } else if (ntile < 10) {
#pragma unroll
        for (int e = 0; e < 8; ++e) v[e] = silu(v[e]);
        *(u32x4*)((u16*)(ws + R_GA) + (size_t)grow * 512 + (gcol - 768)) = pack8(v);
      } else if (ntile < 14) {
        *(u32x4*)((u16*)(ws + R_UB) + (size_t)grow * 512 + (gcol - 1280)) = pack8(v);
      } else {
#pragma unroll
        for (int e = 0; e < 8; ++e) v[e] = silu(v[e]);
        *(u32x4*)((u16*)(ws + R_GB) + (size_t)grow * 512 + (gcol - 1792)) = pack8(v);
      }
    }
    return;
  }
  if (EPI == EPI_ODD) {
    if (ntile >= 8 && ntile < 12) {
#pragma unroll
      for (int it = 0; it < 8; ++it) {
        const int item = it * 256 + tid, row = item >> 4, col0 = (item & 15) * 8;
        const int grow = m0 + row;
        if (grow < TP) {
          float* d = p.out + O_CV + (size_t)grow * 512 + (n0 - 1024) + col0;
          *(f32x4*)d = *(const f32x4*)(Cs + row * CSTR + col0); *(f32x4*)(d + 4) = *(const f32x4*)(Cs + row * CSTR + col0 + 4);
        }
      }
      store_vt_tile(Cs, m0, tid, (u16*)(ws + R_VTCP), (u16*)(ws + R_VTCS), 8, (n0 - 1024) >> 6, nullptr, 0, 0, 1.f, false);
      return;
    }
    const float* ropec = (const float*)(ws + OFF_ROPED);
    const float* ropes = ropec + 64 * 8;
    float* ssq = (float*)(ws + OFF_SSQ);
#pragma unroll
    for (int it = 0; it < 8; ++it) {
      const int item = it * 256 + tid, row = item >> 4, c8 = item & 15, col0 = c8 * 8;
      const int grow = m0 + row, gcol = n0 + col0;
      float v[8];
      ld8(Cs + row * CSTR + col0, v);
      if (ntile < 4) {
        *(u32x4*)((u16*)(ws + R_QC) + (size_t)grow * 512 + gcol) = pack8(v);
      } else if (ntile < 8) {
        const RowInfo ri = row_info(grow);
        if (!ri.samp) { float* d = p.out + O_CK + (size_t)grow * 512 + (gcol - 512); st8(d, v); }
        *(u32x4*)((u16*)(ws + R_KC) + (size_t)ri.krow * 512 + (gcol - 512)) = pack8(v);
      } else if (ntile < 16) {
#pragma unroll
        for (int e = 0; e < 8; ++e) v[e] = silu(v[e]);
        *(u32x4*)((u16*)(ws + R_GC) + (size_t)grow * 512 + (gcol - 1536)) = pack8(v);
      } else if (ntile < 20) {
#pragma unroll
        for (int e = 0; e < 8; ++e) v[e] = silu(v[e]);
        *(u32x4*)((u16*)(ws + R_GD) + (size_t)grow * 512 + (gcol - 2048)) = pack8(v);
      } else if (ntile < 23) {
        float ss = 0.f;
#pragma unroll
        for (int e = 0; e < 8; ++e) ss += v[e] * v[e];
        ss = red8(ss);
        if ((c8 & 7) == 0) ssq[(size_t)grow * 16 + ((gcol - 2560) >> 6)] = ss;
        *(u32x4*)((u16*)(ws + R_CQ) + (size_t)grow * 384 + (gcol - 2560)) = pack8(v);
      } else if (ntile < 25) {
        float ss = 0.f;
#pragma unroll
        for (int e = 0; e < 8; ++e) ss += v[e] * v[e];
        ss = red8(ss);
        if ((c8 & 7) == 0) ssq[(size_t)grow * 16 + 8 + ((gcol - 2944) >> 6)] = ss;
        *(u32x4*)((u16*)(ws + R_CKV) + (size_t)grow * 256 + (gcol - 2944)) = pack8(v);
        if (grow < TP) { float* d = p.out + O_CKV + (size_t)grow * 256 + (gcol - 2944); st8(d, v); }
      } else {
        if (c8 < 4) {
          const RowInfo ri = row_info(grow);
          const int d0 = col0;
          if (!ri.samp) { float* d = p.out + O_KPE + (size_t)grow * 32 + d0; st8(d, v); }
          else {
            const int pc = col0 ^ 8;
            float pv[8];
            ld8(Cs + row * CSTR + pc, pv);
            const int pos = (d0 < 16) ? (ri.t >> 6) : (ri.t & 63);
            const float sgn = (d0 & 8) ? 1.f : -1.f;
#pragma unroll
            for (int e = 0; e < 8; ++e) {
              const float cs = ropec[pos * 8 + e], sn = ropes[pos * 8 + e];
              v[e] = v[e] * cs + sgn * pv[e] * sn;
            }
          }
          *(u32x4*)((u16*)(ws + OFF_KPE) + (size_t)ri.krow * 32 + d0) = pack8(v);
        }
      }
    }
    return;
  }
  if (EPI == EPI_Q) {
    const float* ropec = (const float*)(ws + OFF_ROPED);
    const float* ropes = ropec + 64 * 8;
    const float* ssq = (const float*)(ws + OFF_SSQ);
    u16* Qd = (u16*)(ws + R_QD);
#pragma unroll
    for (int it = 0; it < 8; ++it) {
      const int item = it * 256 + tid, row = item >> 4, col0 = (item & 15) * 8;
      const int grow = m0 + row, gcol = n0 + col0;
      float s = 0.f;
#pragma unroll
      for (int q = 0; q < 6; ++q) s += ssq[(size_t)grow * 16 + q];
      const float r = rsqrtf(s * (1.f / 384.f) + EPS);
      float v[8];
      ld8(Cs + row * CSTR + col0, v);
#pragma unroll
      for (int e = 0; e < 8; ++e) v[e] *= r;
      if (gcol < 512) {
        const int head = gcol >> 6, d = gcol & 63;
        *(u32x4*)(Qd + (size_t)grow * 768 + head * 96 + d) = pack8(v);
      } else {
        const int m = gcol - 512, head = m >> 5, d0 = m & 31;
        const RowInfo ri = row_info(grow);
        if (ri.samp) {
          const int pc = col0 ^ 8;
          float pv[8];
          ld8(Cs + row * CSTR + pc, pv);
          const int pos = (d0 < 16) ? (ri.t >> 6) : (ri.t & 63);
          const float sgn = (d0 & 8) ? 1.f : -1.f;
#pragma unroll
          for (int e = 0; e < 8; ++e) {
            const float cs = ropec[pos * 8 + e], sn = ropes[pos * 8 + e];
            v[e] = v[e] * cs + sgn * (pv[e] * r) * sn;
          }
        }
        *(u32x4*)(Qd + (size_t)grow * 768 + head * 96 + 64 + d0) = pack8(v);
      }
    }
    return;
  }
  if (EPI == EPI_KV || EPI == EPI_KVCTX) {
    const float* ssq = (const float*)(ws + OFF_SSQ);
    if (n0 >= 512) {
      store_vt_tile(Cs, m0, tid, (u16*)(ws + R_VTDP), (u16*)(ws + R_VTDS), 8, (n0 - 512) >> 6,
                    EPI == EPI_KV ? ssq : nullptr, 8, 4, 256.f, EPI == EPI_KVCTX);
      return;
    }
    u16* Kd = (u16*)(ws + R_KD);
#pragma unroll
    for (int it = 0; it < 8; ++it) {
      const int item = it * 256 + tid, row = item >> 4, col0 = (item & 15) * 8;
      const int grow = m0 + row, gcol = n0 + col0;
      float r = 1.f; int krow;
      if (EPI == EPI_KV) {
        float s = 0.f;
#pragma unroll
        for (int q = 0; q < 4; ++q) s += ssq[(size_t)grow * 16 + 8 + q];
        r = rsqrtf(s * (1.f / 256.f) + EPS);
        krow = row_info(grow).krow;
      } else {
        krow = TP + (grow >> 9) * NKS + (grow & 511);
      }
      float v[8];
      ld8(Cs + row * CSTR + col0, v);
#pragma unroll
      for (int e = 0; e < 8; ++e) v[e] *= r;
      *(u32x4*)(Kd + (size_t)krow * 512 + gcol) = pack8(v);
    }
    return;
  }
}

struct AttnJob {
  const u16* Q; int q_stride;
  const u16* K; int k_stride;
  const u16* K2;
  const u16* Vt; int nk;
  const u16* G;
  u16* U;
  int qrow0;
  int ntiles;
  float sc;
  int qt2; const float* rpb;
  int tid;
};

constexpr int VROW = 136;
template <int DK>
struct AttnCfg { static constexpr int KROW = DK * 2 + 16; static constexpr int STAGE = 64 * (KROW + VROW); static constexpr int KCH = DK / 8; static constexpr int NKL = (64 * KCH) / 256; };
constexpr int RPB_OFF = 45056;

template <int DK, bool NA>
DI void attn_item(const AttnJob& j, char* smem) {
  typedef AttnCfg<DK> C;
  const int tid = j.tid, lane = tid & 63, wid = tid >> 6, l31 = lane & 31, lh = lane >> 5;
  int r0e = 0;
  float* rpbl = (float*)(smem + RPB_OFF);
  if (NA) {
    r0e = min(max(2 * j.qt2 - 4, 0), 56);
    for (int i = tid; i < 465; i += 256) rpbl[i] = j.rpb[i] * LOG2E;
  }
  bf16x8 qf[DK / 16];
  {
    const u16* qp = j.Q + (size_t)(j.qrow0 + wid * 32 + l31) * j.q_stride + lh * 8;
#pragma unroll
    for (int kk = 0; kk < DK / 16; ++kk) qf[kk] = *(const bf16x8*)(qp + kk * 16);
  }
  f32x16 o[2];
#pragma unroll
  for (int a = 0; a < 2; ++a)
#pragma unroll
    for (int i = 0; i < 16; ++i) o[a][i] = 0.f;
  float m_run = -INFINITY, l_run = 0.f;
  u32x4 rk[C::NKL], rv[2];
#define KEY0(jt) (NA ? ((jt) < 8 ? (jt) * 64 : 512 + (r0e + (jt) - 8) * 64) : (jt) * 64)
#define A_LOAD(jt)                                                                                   \
  {                                                                                                  \
    const int key0 = KEY0(jt);                                                                       \
    _Pragma("unroll") for (int i = 0; i < C::NKL; ++i) {                                             \
      const int c = tid + 256 * i, row = c / C::KCH, ch = c % C::KCH;                                \
      if (DK == 96 && ch >= 8) rk[i] = *(const u32x4*)(j.K2 + (size_t)(key0 + row) * 32 + (ch - 8) * 8); \
      else rk[i] = *(const u32x4*)(j.K + (size_t)(key0 + row) * j.k_stride + ch * 8);                \
    }                                                                                                \
    _Pragma("unroll") for (int i = 0; i < 2; ++i) {                                                  \
      const int c = tid + 256 * i, row = c >> 3, ch = c & 7;                                         \
      rv[i] = *(const u32x4*)(j.Vt + (size_t)row * j.nk + key0 + ch * 8);                            \
    }                                                                                                \
  }
#define A_STORE(st)                                                                                  \
  {                                                                                                  \
    char* sk = smem + (st) * C::STAGE;                                                               \
    char* sv = sk + 64 * C::KROW;                                                                    \
    _Pragma("unroll") for (int i = 0; i < C::NKL; ++i) {                                             \
      const int c = tid + 256 * i, row = c / C::KCH, ch = c % C::KCH;                                \
      *(u32x4*)(sk + row * C::KROW + ch * 16) = rk[i];                                               \
    }                                                                                                \
    _Pragma("unroll") for (int i = 0; i < 2; ++i) {                                                  \
      const int c = tid + 256 * i, row = c >> 3, ch = c & 7;                                         \
      u32x2 lo, hi; lo[0] = rv[i][0]; lo[1] = rv[i][1]; hi[0] = rv[i][2]; hi[1] = rv[i][3];          \
      *(u32x2*)(sv + row * VROW + ch * 16) = lo;                                                     \
      *(u32x2*)(sv + row * VROW + ch * 16 + 8) = hi;                                                 \
    }                                                                                                \
  }
  A_LOAD(0);
  A_STORE(0);
  __syncthreads();
  const int qr = 2 * j.qt2 + (wid >> 1), qc = (wid & 1) * 32 + l31;
  const int r0 = min(max(qr - 4, 0), 56), c0 = min(max(qc - 8, 0), 48);
  for (int jt = 0; jt < j.ntiles; ++jt) {
    if (jt + 1 < j.ntiles) A_LOAD(jt + 1);
    __builtin_amdgcn_sched_barrier(0);
    const char* sk = smem + (jt & 1) * C::STAGE;
    const char* sv = sk + 64 * C::KROW;
    bool skip_tile = false;
    if (NA && jt >= 8) { const int kr_ = r0e + jt - 8; skip_tile = !((kr_ >= r0) && (kr_ < r0 + 8)); }
    if (!skip_tile) {
    f32x16 s[2];
#pragma unroll
    for (int a = 0; a < 2; ++a)
#pragma unroll
      for (int i = 0; i < 16; ++i) s[a][i] = 0.f;
    {
      bf16x8 kf[2][2];
#define LDK(buf, kk) { _Pragma("unroll") for (int mt = 0; mt < 2; ++mt) kf[buf][mt] = *(const bf16x8*)(sk + (mt * 32 + l31) * C::KROW + (kk) * 32 + lh * 16); }
      LDK(0, 0);
      __builtin_amdgcn_s_setprio(1);
#pragma unroll
      for (int kk = 0; kk < DK / 16; ++kk) {
        if (kk + 1 < DK / 16) LDK((kk + 1) & 1, kk + 1);
        __builtin_amdgcn_sched_barrier(0);
#pragma unroll
        for (int mt = 0; mt < 2; ++mt) s[mt] = mfma32(kf[kk & 1][mt], qf[kk], s[mt]);
        __builtin_amdgcn_sched_barrier(0);
      }
      __builtin_amdgcn_s_setprio(0);
#undef LDK
    }
    u32x4 vfr[2][2];
#define LDV(buf, sp)                                                                                 \
  {                                                                                                  \
    _Pragma("unroll") for (int dt = 0; dt < 2; ++dt) {                                               \
      const char* vp = sv + (dt * 32 + l31) * VROW + (16 * (sp) + 4 * lh) * 2;                       \
      const u32x2 lo = *(const u32x2*)vp, hi = *(const u32x2*)(vp + 16);                             \
      vfr[buf][dt][0] = lo[0]; vfr[buf][dt][1] = lo[1]; vfr[buf][dt][2] = hi[0]; vfr[buf][dt][3] = hi[1]; \
    }                                                                                                \
  }
    LDV(0, 0);
    __builtin_amdgcn_sched_barrier(0);
    float mxs;
    if (NA && jt >= 8) {
      const int kr = r0e + jt - 8;
      const bool rowok = (kr >= r0) && (kr < r0 + 8);
      const float* bl = rpbl + (kr - qr + 7) * 31 + (15 - qc);
      float mx = -INFINITY;
#pragma unroll
      for (int mt = 0; mt < 2; ++mt)
#pragma unroll
        for (int i = 0; i < 16; ++i) {
          const int kc = 32 * mt + (i & 3) + 8 * (i >> 2) + 4 * lh;
          const bool ok = rowok && (kc >= c0) && (kc < c0 + 16);
          float bias = 0.f;
          if (ok) bias = bl[kc];
          const float t = ok ? (s[mt][i] * j.sc + bias) : -INFINITY;
          s[mt][i] = t;
          mx = fmaxf(mx, t);
        }
      mxs = xhalf_max(mx);
    } else {
      float mx = -INFINITY;
#pragma unroll
      for (int mt = 0; mt < 2; ++mt)
#pragma unroll
        for (int i = 0; i < 16; ++i) mx = fmaxf(mx, s[mt][i]);
      mx = xhalf_max(mx);
      mxs = mx * j.sc;
    }
    if (__any(mxs > m_run + 8.f)) {
      const float m_new = fmaxf(m_run, mxs);
      const float alpha = __builtin_amdgcn_exp2f(m_run - m_new);
      m_run = m_new;
      l_run *= alpha;
      const f32x2 a2 = {alpha, alpha};
#pragma unroll
      for (int a = 0; a < 2; ++a)
#pragma unroll
        for (int i = 0; i < 8; ++i) {
          f32x2 v = {o[a][2 * i], o[a][2 * i + 1]};
          v = v * a2;
          o[a][2 * i] = v[0]; o[a][2 * i + 1] = v[1];
        }
    }
    {
      f32x2 ps2 = {0.f, 0.f};
      const f32x2 nm2 = {-m_run, -m_run};
      const bool raw = !(NA && jt >= 8);
      const float scl = raw ? j.sc : 1.f;
      const f32x2 sc2 = {scl, scl};
#pragma unroll
      for (int mt = 0; mt < 2; ++mt)
#pragma unroll
        for (int i = 0; i < 8; ++i) {
          f32x2 v = {s[mt][2 * i], s[mt][2 * i + 1]};
          v = v * sc2 + nm2;
          f32x2 e = {__builtin_amdgcn_exp2f(v[0]), __builtin_amdgcn_exp2f(v[1])};
          s[mt][2 * i] = e[0]; s[mt][2 * i + 1] = e[1];
          ps2 += e;
        }
      l_run += ps2[0] + ps2[1];
    }
    __builtin_amdgcn_s_setprio(1);
#pragma unroll
    for (int sp = 0; sp < 4; ++sp) {
      const int mt = sp >> 1, s8 = (sp & 1) * 8;
      u32x4 pu;
      pu[0] = pack2(s[mt][s8 + 0], s[mt][s8 + 1]); pu[1] = pack2(s[mt][s8 + 2], s[mt][s8 + 3]);
      pu[2] = pack2(s[mt][s8 + 4], s[mt][s8 + 5]); pu[3] = pack2(s[mt][s8 + 6], s[mt][s8 + 7]);
      const bf16x8 pb = __builtin_bit_cast(bf16x8, pu);
      if (sp + 1 < 4) LDV((sp + 1) & 1, sp + 1);
      __builtin_amdgcn_sched_barrier(0);
#pragma unroll
      for (int dt = 0; dt < 2; ++dt) o[dt] = mfma32(__builtin_bit_cast(bf16x8, vfr[sp & 1][dt]), pb, o[dt]);
      __builtin_amdgcn_sched_barrier(0);
    }
    __builtin_amdgcn_s_setprio(0);
#undef LDV
    }
    __builtin_amdgcn_sched_barrier(0);
    if (jt + 1 < j.ntiles) A_STORE((jt + 1) & 1);
    __syncthreads();
  }
#undef A_LOAD
#undef A_STORE
#undef KEY0
  const float lt = xhalf_sum(l_run);
  const float inv = 1.f / lt;
  const int qrow = j.qrow0 + wid * 32 + l31;
  const u16* gp = j.G + (size_t)qrow * 512;
  u16* up = j.U + (size_t)qrow * 1024;
#pragma unroll
  for (int dt = 0; dt < 2; ++dt)
#pragma unroll
    for (int g4 = 0; g4 < 4; ++g4) {
      const int d = dt * 32 + 8 * g4 + 4 * lh;
      u32x2 gg = *(const u32x2*)(gp + d);
      u32x2 ov;
      ov[0] = pack2(o[dt][g4 * 4 + 0] * inv * bflo(gg[0]), o[dt][g4 * 4 + 1] * inv * bfhi(gg[0]));
      ov[1] = pack2(o[dt][g4 * 4 + 2] * inv * bflo(gg[1]), o[dt][g4 * 4 + 3] * inv * bfhi(gg[1]));
      *(u32x2*)(up + d) = ov;
    }
}

DI int perm_src(int perm, int n) {
  switch (perm) {
    case 0: return n;
    case 1:
      if (n < 2048) return n;
      if (n < 2560) return 2720 + (n - 2048);
      if (n < 2944) return 2048 + (n - 2560);
      if (n < 3200) return 2432 + (n - 2944);
      if (n < 3232) return 2688 + (n - 3200);
      return -1;
    case 2:
      if (n < 512) return (n >> 6) * 96 + (n & 63);
      return ((n - 512) >> 5) * 96 + 64 + ((n - 512) & 31);
    default:
      if (n < 512) return (n >> 6) * 128 + (n & 63);
      return ((n - 512) >> 6) * 128 + 64 + ((n - 512) & 63);
  }
}

DI void transpose_tile(const float* src, const float* g, u16* dst, int K, int Nsrc, int perm, int k0, int n0, char* smem, int tid) {
  float* tile = (float*)smem;
  {
    const int nn = tid & 63, kq = tid >> 6;
    const int sc = perm_src(perm, n0 + nn);
    float tv[16];
#pragma unroll
    for (int i = 0; i < 16; ++i) {
      const int k = kq + 4 * i;
      tv[i] = (sc >= 0) ? __builtin_nontemporal_load(&src[(size_t)(k0 + k) * Nsrc + sc]) : 0.f;
    }
#pragma unroll
    for (int i = 0; i < 16; ++i) {
      const int k = kq + 4 * i;
      float v = tv[i];
      if (g) v *= g[k0 + k];
      tile[k * 65 + nn] = v;
    }
  }
  __syncthreads();
  {
    const int kp = tid & 31, nb = tid >> 5;
#pragma unroll
    for (int i = 0; i < 8; ++i) {
      const int n = nb + 8 * i;
      const u32 v = pack2(tile[(2 * kp) * 65 + n], tile[(2 * kp + 1) * 65 + n]);
      *(u32*)(dst + (size_t)(n0 + n) * K + k0 + 2 * kp) = v;
    }
  }
  __syncthreads();
}

DI void mod_item(const Params& p, int item, char* smem) {
  const int ke = item & 7, cchunk = (item >> 3) % 48, layer = item / 384;
  const int c0 = cchunk * 64, k0 = ke * 128;
  float* sl = (float*)smem;
  float* red = sl + 5 * 128;
  const int tid = p.tid;
  for (int i = tid; i < 5 * 128; i += 256) {
    const int r = i >> 7, k = k0 + (i & 127);
    const float c = (r == 0) ? p.c_ctx[k] : p.c[(r - 1) * 1024 + k];
    sl[i] = silu(c);
  }
  __syncthreads();
  const int col = tid & 63, kw = tid >> 6;
  float acc[5] = {0.f, 0.f, 0.f, 0.f, 0.f};
  const float* w = p.w_mod + ((size_t)layer * 1024 + k0 + kw * 32) * 3072 + c0 + col;
#pragma unroll
  for (int k = 0; k < 32; ++k) {
    const float wv = __builtin_nontemporal_load(&w[(size_t)k * 3072]);
#pragma unroll
    for (int r = 0; r < 5; ++r) acc[r] += sl[r * 128 + kw * 32 + k] * wv;
  }
#pragma unroll
  for (int r = 0; r < 5; ++r) red[(kw * 5 + r) * 64 + col] = acc[r];
  __syncthreads();
  for (int i = tid; i < 5 * 64; i += 256) {
    const int r = i >> 6, cc = i & 63;
    float s = red[(0 * 5 + r) * 64 + cc] + red[(1 * 5 + r) * 64 + cc] + red[(2 * 5 + r) * 64 + cc] + red[(3 * 5 + r) * 64 + cc];
    if (ke == 0) s += p.b_mod[layer * 3072 + c0 + cc];
    atomicAdd((float*)(p.ws + OFF_MOD) + (layer * 5 + r) * 3072 + c0 + cc, s);
  }
  __syncthreads();
}

DI void phase0(const Params& p, char* smem) {
  char* ws = p.ws;
  const int NTR = 576 + 256 + 832 + 256 + 72 + 64 + 64 + 16;
  for (int item = p.bid; item < NTR + 768; item += gridDim.x) {
    if (item >= NTR) {
      mod_item(p, item - NTR, smem);
      continue;
    }
    int it = item;
    const float* src; const float* g = nullptr; u16* dst; int K, Nsrc, perm, tn;
    if (it < 576) { src = p.w_in_e; dst = (u16*)(ws + OFF_WINE); K = 1024; Nsrc = 2304; perm = 0; tn = 36; }
    else if ((it -= 576) < 256) { src = p.w_out_e; dst = (u16*)(ws + OFF_WOUTE); K = 1024; Nsrc = 1024; perm = 0; tn = 16; }
    else if ((it -= 256) < 832) { src = p.w_in_o; dst = (u16*)(ws + OFF_WINO); K = 1024; Nsrc = 3232; perm = 1; tn = 52; }
    else if ((it -= 832) < 256) { src = p.w_out_o; dst = (u16*)(ws + OFF_WOUTO); K = 1024; Nsrc = 1024; perm = 0; tn = 16; }
    else if ((it -= 256) < 72) { src = p.d_w_uq; g = p.d_q_norm; dst = (u16*)(ws + OFF_WUQ); K = 384; Nsrc = 768; perm = 2; tn = 12; }
    else if ((it -= 72) < 64) { src = p.d_w_ukv; g = p.d_kv_norm; dst = (u16*)(ws + OFF_WUKVG); K = 256; Nsrc = 1024; perm = 3; tn = 16; }
    else if ((it -= 64) < 64) { src = p.d_w_ukv; dst = (u16*)(ws + OFF_WUKV); K = 256; Nsrc = 1024; perm = 3; tn = 16; }
    else { it -= 64; const int gq = it >> 2; it &= 3; src = p.b_map + (size_t)gq * 128 * 128; dst = (u16*)(ws + OFF_WBMAP) + (size_t)gq * 128 * 128; K = 128; Nsrc = 128; perm = 0; tn = 2; }
    transpose_tile(src, g, dst, K, Nsrc, perm, (it / tn) * 64, (it % tn) * 64, smem, p.tid);
  }
  const int gt = p.bid * 256 + p.tid, gs = gridDim.x * 256;
  for (int i = gt; i < 64 * 16 + 64 * 8; i += gs) {
    if (i < 1024) {
      const int pos = i >> 4, f = i & 15;
      const float inv = powf(10000.f, -(float)(2 * f) / 32.f);
      const float ang = (float)pos * inv;
      ((float*)(ws + OFF_ROPEA))[i] = cosf(ang);
      ((float*)(ws + OFF_ROPEA))[1024 + i] = sinf(ang);
    } else {
      const int q = i - 1024, pos = q >> 3, f = q & 7;
      const float inv = powf(10000.f, -(float)(2 * f) / 16.f);
      const float ang = (float)pos * inv;
      ((float*)(ws + OFF_ROPED))[q] = cosf(ang);
      ((float*)(ws + OFF_ROPED))[512 + q] = sinf(ang);
    }
  }
  for (int i = gt; i < 4 * 512 * 128; i += gs) {
    const int b = i >> 16, n = (i >> 7) & 511, cc = i & 127;
    ((u16*)(ws + R_KA))[(size_t)(TP + b * NKS + n) * 128 + cc] = f2bf(p.cache_a_k[i]);
    const int kvh = cc >> 6, d = cc & 63;
    ((u16*)(ws + R_VTAS))[((size_t)(b * 2 + kvh) * 64 + d) * NKS + n] = f2bf(p.cache_a_v[i]);
  }
  for (int i = gt; i < 2048 * 256; i += gs) ((u16*)(ws + OFF_CKVCTX))[i] = f2bf(p.cache_d_ckv[i]);
  for (int i = gt; i < 4 * 512 * 32; i += gs) {
    const int b = i >> 14, n = (i >> 5) & 511, d = i & 31;
    ((u16*)(ws + OFF_KPE))[(size_t)(TP + b * NKS + n) * 32 + d] = f2bf(p.cache_d_kpe[i]);
  }
}

template <int MODE>
DI void norm_phase(const Params& p) {
  const int lane = p.tid & 63, wid = p.tid >> 6;
  const float* mod = (const float*)(p.ws + OFF_MOD);
  u16* H = (u16*)(p.ws + OFF_HU);
  const u16* Y = (const u16*)(p.ws + R_Y);
  constexpr int NR = 2;
  const int stride = gridDim.x * 4;
  f32x4 xv[NR][4], xn[NR][4];
  u32x2 yb[NR][4], yn[NR][4];
#define N_LOAD(XV, YB, R0)                                                                           \
  {                                                                                                  \
    _Pragma("unroll") for (int r = 0; r < NR; ++r) {                                                 \
      const int row = (R0) + r * stride;                                                             \
      if (row < T) {                                                                                 \
        const float* xin = (row < TP) ? p.x_prompt + (size_t)row * 1024 : p.x_sample + (size_t)(row - TP) * 1024; \
        const float* xsrc = (MODE == 2) ? p.out + (size_t)row * 1024 : xin;                          \
        _Pragma("unroll") for (int i = 0; i < 4; ++i) {                                              \
          XV[r][i] = __builtin_nontemporal_load((const f32x4*)(xsrc + lane * 4 + 256 * i));          \
          if (MODE != 0) YB[r][i] = __builtin_nontemporal_load((const u32x2*)(Y + (size_t)row * 1024 + lane * 4 + 256 * i)); \
        }                                                                                            \
      }                                                                                              \
    }                                                                                                \
  }
  f32x4 gpost_r[4], gpre_r[4];
#pragma unroll
  for (int i = 0; i < 4; ++i) {
    const int cc = lane * 4 + 256 * i;
    gpost_r[i] = (MODE != 0) ? *(const f32x4*)(p.g_post + (MODE - 1) * 1024 + cc) : f32x4{0.f, 0.f, 0.f, 0.f};
    gpre_r[i] = (MODE != 2) ? *(const f32x4*)(p.g_pre + ((MODE == 0) ? 0 : 1) * 1024 + cc) : f32x4{0.f, 0.f, 0.f, 0.f};
  }
  f32x4 gt_r[4], sc_r[4], sh_r[4];
  int mrow_cached = -1;
  int row0 = p.bid * 4 + wid;
  if (row0 < T) N_LOAD(xv, yb, row0);
  for (; row0 < T; row0 += stride * NR) {
    const int rown = row0 + stride * NR;
    if (rown < T) N_LOAD(xn, yn, rown);
    __builtin_amdgcn_sched_barrier(0);
#pragma unroll
    for (int r = 0; r < NR; ++r) {
      const int row = row0 + r * stride;
      if (row >= T) continue;
      const int mrow = (row < TP) ? 0 : 1 + ((row - TP) >> 12);
      if (mrow != mrow_cached) {
        mrow_cached = mrow;
#pragma unroll
        for (int i = 0; i < 4; ++i) {
          const int cc = lane * 4 + 256 * i;
          if (MODE != 0) gt_r[i] = *(const f32x4*)(mod + ((MODE - 1) * 5 + mrow) * 3072 + 2048 + cc);
          if (MODE != 2) {
            sh_r[i] = *(const f32x4*)(mod + (((MODE == 0) ? 0 : 1) * 5 + mrow) * 3072 + cc);
            sc_r[i] = *(const f32x4*)(mod + (((MODE == 0) ? 0 : 1) * 5 + mrow) * 3072 + 1024 + cc);
          }
        }
      }
      float* orow = p.out + (size_t)row * 1024;
      if (MODE != 0) {
        const int L = MODE - 1;
        const float* gate = mod + (L * 5 + mrow) * 3072 + 2048;
        const float* gpost = p.g_post + L * 1024;
        f32x4 yv[4];
        float ss = 0.f;
#pragma unroll
        for (int i = 0; i < 4; ++i) {
          yv[i][0] = bflo(yb[r][i][0]); yv[i][1] = bfhi(yb[r][i][0]); yv[i][2] = bflo(yb[r][i][1]); yv[i][3] = bfhi(yb[r][i][1]);
#pragma unroll
          for (int e = 0; e < 4; ++e) ss += yv[i][e] * yv[i][e];
        }
        ss = wave_sum(ss);
        const float ry = rsqrtf(ss * (1.f / 1024.f) + EPS);
#pragma unroll
        for (int i = 0; i < 4; ++i) {
          const int cc = lane * 4 + 256 * i;
          const f32x4 gt4 = gt_r[i], gp4 = gpost_r[i];
#pragma unroll
          for (int e = 0; e < 4; ++e) xv[r][i][e] = xv[r][i][e] + gt4[e] * (yv[i][e] * ry * gp4[e]);
          __builtin_nontemporal_store(xv[r][i], (f32x4*)(orow + cc));
        }
        if (MODE == 2) continue;
      }
      const int L2 = (MODE == 0) ? 0 : 1;
      const float* shift = mod + (L2 * 5 + mrow) * 3072;
      const float* scale = shift + 1024;
      const float* gpre = p.g_pre + L2 * 1024;
      float ss = 0.f;
#pragma unroll
      for (int i = 0; i < 4; ++i)
#pragma unroll
        for (int e = 0; e < 4; ++e) ss += xv[r][i][e] * xv[r][i][e];
      ss = wave_sum(ss);
      const float rx = rsqrtf(ss * (1.f / 1024.f) + EPS);
#pragma unroll
      for (int i = 0; i < 4; ++i) {
        const int cc = lane * 4 + 256 * i;
        const f32x4 g4 = gpre_r[i], sc4 = sc_r[i], sh4 = sh_r[i];
        float hv[4];
#pragma unroll
        for (int e = 0; e < 4; ++e) hv[e] = xv[r][i][e] * rx * g4[e] * (1.f + sc4[e]) + sh4[e];
        u32x2 o2; o2[0] = pack2(hv[0], hv[1]); o2[1] = pack2(hv[2], hv[3]);
        *(u32x2*)(H + (size_t)row * 1024 + cc) = o2;
      }
    }
#pragma unroll
    for (int r = 0; r < NR; ++r)
#pragma unroll
      for (int i = 0; i < 4; ++i) { xv[r][i] = xn[r][i]; yb[r][i] = yn[r][i]; }
  }
#undef N_LOAD
}

#define GEMM_XCD_LOOP(MT, NT, EPI_)                                                                  \
  {                                                                                                  \
      \
    constexpr int MX_ = (MT) >> 3;                                                                   \
    constexpr int W_ = ((NT) <= 8) ? (NT) : (((NT) % 6 == 0) ? 6 : 7);                               \
    constexpr int NFULL_ = (NT) / W_;                                                                \
    constexpr int NTC_ = (NT);                                                                       \
    const int xcd_ = p.bid & 7, li_ = p.bid >> 3, nb_ = gridDim.x >> 3;                              \
    GemmPre pre_;                                                                                    \
    bool have_ = false;                                                                              \
    int nmt_ = -1, nnt_ = 0;                                                                         \
    for (int idx_ = (p.bid < nb_ * 8) ? li_ : 0x7fffffff; idx_ < MX_ * (NT); idx_ += nb_) {         \
      int mt_, nt_;                                                                                  \
      if (have_) { mt_ = nmt_; nt_ = nnt_; }                                                         \
      else { GEMM_IDX(idx_, mt_, nt_); }                                                             \
      const int nx_ = idx_ + nb_;                                                                    \
      const bool hn_ = nx_ < MX_ * (NT);                                                             \
      if (hn_) { GEMM_IDX(nx_, nmt_, nnt_); }                                                        \
      gemm_tile<EPI_, AL_PLAIN>(p, j, mt_ * 128, nt_ * 128, smem, pre_, have_, hn_ ? nmt_ * 128 : -1, nnt_ * 128); \
      have_ = hn_;                                                                                   \
    }                                                                                                \
  }
#define GEMM_IDX(i_, mo_, no_)                                                                       \
  {                                                                                                  \
    int win_, rem_, wl_;                                                                             \
    if ((i_) < NFULL_ * MX_ * W_) { win_ = (i_) / (MX_ * W_); rem_ = (i_) % (MX_ * W_); wl_ = W_; }  \
    else { win_ = NFULL_; rem_ = (i_) - NFULL_ * MX_ * W_; wl_ = NTC_ - NFULL_ * W_; }               \
    mo_ = (rem_ / wl_) * 8 + xcd_; no_ = win_ * W_ + rem_ % wl_;                                     \
  }
DI void attn_sample_common(AttnJob& j, int idx, int& b, int& qt, int& h) { b = idx >> 8; const int rem = idx & 255; qt = rem >> 3; h = rem & 7; j.qrow0 = TP + b * 4096 + qt * 128; j.qt2 = qt; }
DI void attn_prompt_common(AttnJob& j, int idx, int& b, int& qt, int& h) { b = idx >> 4; const int rem = idx & 15; qt = rem >> 3; h = rem & 7; j.qrow0 = b * 256 + qt * 128; j.qt2 = 0; }

DI void run_phase(const Params& p, int ph, char* smem) {
  char* ws = p.ws;
  if (!((PHMASK >> ph) & 1)) return;
  switch (ph) {
    case 0: phase0(p, smem); break;
    case 1: norm_phase<0>(p); break;
    case 2: {
      GemmJob j; j.A = (const u16*)(ws + OFF_HU); j.lda = 1024; j.Bt = (const u16*)(ws + OFF_WINE); j.K = 1024; j.grp = 0;
      GEMM_XCD_LOOP(192, 18, EPI_EVEN)
    } break;
    case 3: {
      for (int item = p.bid; item < 1024 + 512 + 768; item += gridDim.x) {
        if (item < 1536) {
          AttnJob j; j.tid = p.tid; int b, qt, h;
          const bool samp = item < 1024;
          if (samp) attn_sample_common(j, item, b, qt, h); else attn_prompt_common(j, item - 1024, b, qt, h);
          const int kvh = h >> 2;
          const int krow0 = samp ? TP + b * NKS : b * 256;
          j.Q = (const u16*)(ws + R_QA) + h * 64; j.q_stride = 512;
          j.K = (const u16*)(ws + R_KA) + (size_t)krow0 * 128 + kvh * 64; j.k_stride = 128; j.K2 = nullptr;
          j.nk = samp ? NKS : 256;
          j.Vt = samp ? (const u16*)(ws + R_VTAS) + (size_t)((b * 2 + kvh) * 64) * NKS : (const u16*)(ws + R_VTAP) + (size_t)((b * 2 + kvh) * 64) * 256;
          j.G = (const u16*)(ws + R_GA) + h * 64;
          j.U = (u16*)(ws + OFF_HU) + h * 64;
          j.ntiles = j.nk / 64; j.sc = 0.125f * LOG2E; j.rpb = nullptr;
          attn_item<64, false>(j, smem);
        } else {
          const int q = item - 1536;
          pool_tile(p, (q >> 2) * 128, q & 3, smem);
        }
      }
    } break;
    case 4: {
      GemmJob j; j.A = (const u16*)(ws + OFF_HU); j.lda = 1024; j.Bt = (const u16*)(ws + OFF_WOUTE); j.K = 1024; j.grp = 0;
      GEMM_XCD_LOOP(192, 8, EPI_Y)
    } break;
    case 5: norm_phase<1>(p); break;
    case 6: {
      GemmJob j; j.A = (const u16*)(ws + OFF_HU); j.lda = 1024; j.Bt = (const u16*)(ws + OFF_WINO); j.K = 1024; j.grp = 0;
      {
        const int gt = p.bid * 256 + p.tid, gs = gridDim.x * 256;
        for (int i0 = gt; i0 < 4 * 512 * 512; i0 += gs * 8) {
          float kv[8], vv[8];
#pragma unroll
          for (int u = 0; u < 8; ++u) {
            const int i = i0 + u * gs;
            if (i < 4 * 512 * 512) { kv[u] = __builtin_nontemporal_load(&p.cache_c_k[i]); vv[u] = __builtin_nontemporal_load(&p.cache_c_v[i]); }
          }
#pragma unroll
          for (int u = 0; u < 8; ++u) {
            const int i = i0 + u * gs;
            if (i < 4 * 512 * 512) {
              const int b = i >> 18, n = (i >> 9) & 511, cc = i & 511;
              ((u16*)(ws + R_KC))[(size_t)(TP + b * NKS + n) * 512 + cc] = f2bf(kv[u]);
              const int hh = cc >> 6, d = cc & 63;
              ((u16*)(ws + R_VTCS))[((size_t)(b * 8 + hh) * 64 + d) * NKS + n] = f2bf(vv[u]);
            }
          }
        }
      }
      GEMM_XCD_LOOP(192, 26, EPI_ODD)
    } break;
    case 7: {
      for (int item = p.bid; item < 1536; item += gridDim.x) {
        AttnJob j; j.tid = p.tid; int b, qt, h;
        const bool samp = item < 1024;
        if (samp) attn_sample_common(j, item, b, qt, h); else attn_prompt_common(j, item - 1024, b, qt, h);
        const int krow0 = samp ? TP + b * NKS : b * 256;
        j.Q = (const u16*)(ws + R_QC) + h * 64; j.q_stride = 512;
        j.K = (const u16*)(ws + R_KC) + (size_t)krow0 * 512 + h * 64; j.k_stride = 512; j.K2 = nullptr;
        j.nk = samp ? NKS : 256;
        j.Vt = samp ? (const u16*)(ws + R_VTCS) + (size_t)((b * 8 + h) * 64) * NKS : (const u16*)(ws + R_VTCP) + (size_t)((b * 8 + h) * 64) * 256;
        j.G = (const u16*)(ws + R_GC) + h * 64;
        j.U = (u16*)(ws + OFF_HU) + h * 64;
        j.sc = 0.125f * LOG2E; j.rpb = p.c_rpb + h * 465;
        if (samp) {
          const int r0e = min(max(2 * qt - 4, 0), 56), r0o = min(max(2 * qt - 3, 0), 56);
          j.ntiles = 8 + (r0o + 8 - r0e);
          attn_item<64, true>(j, smem);
        } else {
          j.ntiles = 4;
          attn_item<64, false>(j, smem);
        }
      }
    } break;
    case 8: {
      {
        const int gt = p.bid * 256 + p.tid, gs = gridDim.x * 256;
        const float* ssq = (const float*)(ws + OFF_SSQ);
        for (int i0 = gt; i0 < TP * 64; i0 += gs * 4) {
          f32x4 ov[4], sv[4], gv[4];
#pragma unroll
          for (int u = 0; u < 4; ++u) {
            const int i = i0 + u * gs;
            if (i < TP * 64) {
              ov[u] = *(const f32x4*)(p.out + O_CKV + (size_t)i * 4);
              sv[u] = *(const f32x4*)(ssq + (size_t)(i >> 6) * 16 + 8);
              gv[u] = *(const f32x4*)(p.d_kv_norm + (i & 63) * 4);
            }
          }
#pragma unroll
          for (int u = 0; u < 4; ++u) {
            const int i = i0 + u * gs;
            if (i < TP * 64) {
              const float r = rsqrtf((sv[u][0] + sv[u][1] + sv[u][2] + sv[u][3]) * (1.f / 256.f) + EPS);
              f32x4 o4;
#pragma unroll
              for (int e = 0; e < 4; ++e) o4[e] = ov[u][e] * r * gv[u][e];
              *(f32x4*)(p.out + O_CKV + (size_t)i * 4) = o4;
            }
          }
        }
      }
      {
        const int xcd = p.bid & 7, li = p.bid >> 3, nb = gridDim.x >> 3;
        for (int idx = (p.bid < nb * 8) ? li : 0x7fffffff; idx < 144 + 192 + 16; idx += nb) {
          GemmJob j; j.grp = 0;
          GemmPre pre0;
          if (idx < 144) {
            j.A = (const u16*)(ws + R_CQ); j.lda = 384; j.Bt = (const u16*)(ws + OFF_WUQ); j.K = 384;
            gemm_tile<EPI_Q, AL_PLAIN>(p, j, ((idx / 6) * 8 + xcd) * 128, (idx % 6) * 128, smem, pre0, false, -1, 0);
          } else if (idx < 144 + 192) {
            const int q = idx - 144;
            j.A = (const u16*)(ws + R_CKV); j.lda = 256; j.Bt = (const u16*)(ws + OFF_WUKVG); j.K = 256;
            gemm_tile<EPI_KV, AL_PLAIN>(p, j, ((q >> 3) * 8 + xcd) * 128, (q & 7) * 128, smem, pre0, false, -1, 0);
          } else {
            const int q = idx - 144 - 192;
            j.A = (const u16*)(ws + OFF_CKVCTX); j.lda = 256; j.Bt = (const u16*)(ws + OFF_WUKV); j.K = 256;
            gemm_tile<EPI_KVCTX, AL_PLAIN>(p, j, ((q >> 3) * 8 + xcd) * 128, (q & 7) * 128, smem, pre0, false, -1, 0);
          }
        }
      }
    } break;
    case 9: {
      for (int item = p.bid; item < 1536; item += gridDim.x) {
        AttnJob j; j.tid = p.tid; int b, qt, h;
        const bool samp = item < 1024;
        if (samp) attn_sample_common(j, item, b, qt, h); else attn_prompt_common(j, item - 1024, b, qt, h);
        const int krow0 = samp ? TP + b * NKS : b * 256;
        j.Q = (const u16*)(ws + R_QD) + h * 96; j.q_stride = 768;
        j.K = (const u16*)(ws + R_KD) + (size_t)krow0 * 512 + h * 64; j.k_stride = 512;
        j.K2 = (const u16*)(ws + OFF_KPE) + (size_t)krow0 * 32;
        j.nk = samp ? NKS : 256;
        j.Vt = samp ? (const u16*)(ws + R_VTDS) + (size_t)((b * 8 + h) * 64) * NKS : (const u16*)(ws + R_VTDP) + (size_t)((b * 8 + h) * 64) * 256;
        j.G = (const u16*)(ws + R_GD) + h * 64;
        j.U = (u16*)(ws + OFF_HU) + 512 + h * 64;
        j.ntiles = j.nk / 64; j.sc = 0.10206207261596575f * LOG2E; j.rpb = nullptr;
        attn_item<96, false>(j, smem);
      }
    } break;
    case 10: {
      GemmJob j; j.A = (const u16*)(ws + OFF_HU); j.lda = 1024; j.Bt = (const u16*)(ws + OFF_WOUTO); j.K = 1024; j.grp = 0;
      GEMM_XCD_LOOP(192, 8, EPI_Y)
    } break;
    case 11: norm_phase<2>(p); break;
  }
}

#define XB_TMO      128
#define XB_XCNT(j)  (256  + 64 * (j))
#define XB_XSUB(j)  (1280 + 64 * (j))
#define XB_XGEN(j)  (2304 + 64 * (j))
#define XB_TOP      3328
#define XB_TOPGEN   3392
#define XCD_BAR_WORDS 3456
#define XB_SPIN_CAP (1u << 18)
#define LAS __attribute__((address_space(3)))

__device__ __forceinline__ unsigned xb_ld(unsigned* p)              { return __hip_atomic_load(p, __ATOMIC_RELAXED, __HIP_MEMORY_SCOPE_AGENT); }
__device__ __forceinline__ unsigned xb_add(unsigned* p, unsigned v) { return __hip_atomic_fetch_add(p, v, __ATOMIC_RELAXED, __HIP_MEMORY_SCOPE_AGENT); }
__device__ __forceinline__ unsigned xb_xcc_id() { return (unsigned)__builtin_amdgcn_s_getreg((3 << 11) | 20) & 0xFu; }
#define XB_SPIN(cond, bar) do { unsigned _sp = 0; while (cond) { __builtin_amdgcn_s_sleep(1); \
    if ((++_sp & 255u) == 0u) { if (xb_ld(&(bar)[XB_TMO])) break; if (_sp > XB_SPIN_CAP) { atomicAdd(&(bar)[XB_TMO], 1u); break; } } } } while (0)

struct XcdBarrier {
    unsigned* bar; unsigned x;
    volatile LAS unsigned* st;
};

__device__ __forceinline__ XcdBarrier xcd_barrier_post(unsigned* bar, volatile LAS unsigned* st) {
    XcdBarrier b; b.bar = bar; b.x = xb_xcc_id(); b.st = st;
    if (threadIdx.x == 0) (void)xb_add(&bar[XB_XCNT(b.x)], 1u);
    return b;
}
__device__ __forceinline__ void xcd_barrier_complete(unsigned* bar, unsigned x, unsigned& nloc, unsigned& nx) {
    const unsigned G = gridDim.x * gridDim.y * gridDim.z;
    unsigned sum, cnt, mine, sp = 0u;
    for (;;) {
        sum = 0u; cnt = 0u; mine = 0u;
#pragma unroll
        for (unsigned j = 0; j < 16; ++j) { const unsigned c = xb_ld(&bar[XB_XCNT(j)]); sum += c; cnt += (c > 0u) ? 1u : 0u; mine = (j == x) ? c : mine; }
        if (sum == G) break;
        __builtin_amdgcn_s_sleep(1);
        if ((++sp & 255u) == 0u) { if (xb_ld(&bar[XB_TMO])) break; if (sp > XB_SPIN_CAP) { atomicAdd(&bar[XB_TMO], 1u); break; } }
    }
    nloc = mine > 0u ? mine : 1u; nx = cnt > 0u ? cnt : 1u;
}

__device__ __forceinline__ void xcd_barrier(const XcdBarrier& b) {
    asm volatile("s_waitcnt vmcnt(0)" ::: "memory");
    __syncthreads();
    if (threadIdx.x == 0) {
        unsigned* bar = b.bar;
        __builtin_amdgcn_s_waitcnt(0);
        unsigned nloc = b.st[0], nx = b.st[1];
        if (nloc == 0u) { xcd_barrier_complete(bar, b.x, nloc, nx); b.st[0] = nloc; b.st[1] = nx; }
        const unsigned old = xb_add(&bar[XB_XSUB(b.x)], 1u);
        const unsigned gen = old / nloc;
        if (old + 1u == (gen + 1u) * nloc) {
            __builtin_amdgcn_fence(__ATOMIC_RELEASE, "agent");
            asm volatile("s_waitcnt vmcnt(0)" ::: "memory");
            const unsigned og = xb_add(&bar[XB_TOP], 1u);
            const unsigned tg = og / nx;
            if (og + 1u == (tg + 1u) * nx) xb_add(&bar[XB_TOPGEN], 1u);
            else XB_SPIN(xb_ld(&bar[XB_TOPGEN]) == tg, bar);
            __builtin_amdgcn_fence(__ATOMIC_ACQUIRE, "agent");
            xb_add(&bar[XB_XGEN(b.x)], 1u);
            asm volatile("s_waitcnt vmcnt(0)" ::: "memory");
        } else {
            XB_SPIN(xb_ld(&bar[XB_XGEN(b.x)]) == gen, bar);
            __builtin_amdgcn_fence(__ATOMIC_ACQUIRE, "agent");
            asm volatile("s_waitcnt vmcnt(0)" ::: "memory");
        }
    }
    __syncthreads();
}


__global__ void __launch_bounds__(256, 2) mega(Params p0, int ph_lo, int ph_hi) {
  __shared__ __attribute__((aligned(16))) char smem[SMEM_BYTES];
  __shared__ uint4 xb_words;
  if (threadIdx.x == 0) xb_words = make_uint4(0u, 0u, 0u, 0u);
  __syncthreads();
  XcdBarrier xb = xcd_barrier_post((unsigned*)(p0.ws + OFF_BAR), (volatile LAS unsigned*)&xb_words);
  int ph_rep = 0;
  for (int ph = ph_lo; ph < ph_hi; ++ph) {
    Params p = p0;
#define GP(f) p.f = (const float*)(const GLOBAL float*)p0.f;
    GP(x_prompt) GP(x_sample) GP(cache_a_k) GP(cache_a_v) GP(cache_c_k) GP(cache_c_v) GP(cache_d_ckv) GP(cache_d_kpe)
    GP(c) GP(c_ctx) GP(w_mod) GP(b_mod) GP(g_pre) GP(g_post) GP(w_in_e) GP(a_q_norm) GP(a_k_norm) GP(b_map) GP(b_scale) GP(w_out_e)
    GP(w_in_o) GP(c_rpb) GP(d_q_norm) GP(d_w_uq) GP(d_kv_norm) GP(d_w_ukv) GP(w_out_o)
#undef GP
    int tid = threadIdx.x, bid = blockIdx.x;
    GLOBAL char* ws = (GLOBAL char*)p0.ws; GLOBAL float* out = (GLOBAL float*)p0.out;
    asm volatile("" : "+v"(tid));
    asm volatile("" : "+s"(bid));
    asm volatile("" : "+s"(ws));
    asm volatile("" : "+s"(out));
    p.tid = tid; p.bid = bid; p.ws = (char*)ws; p.out = (float*)out;
#if REPEAT_MASK
    if ((REPEAT_MASK >> ph) & 1) ph_rep ^= 1;
#endif
    run_phase(p, ph, smem);
#if REPEAT_MASK
    if (ph_rep) { --ph; xcd_barrier(xb); continue; }
#endif
    if (ph + 1 < ph_hi) xcd_barrier(xb);
    if (ph_hi < 0) cg::this_grid().sync();
  }
}

extern "C" void kernel_launch(void* const* d_in, const int* in_sizes, int n_in, void* d_out, int out_size, void* d_ws, size_t ws_size, hipStream_t stream) {
  static int grid = 0;
  if (!grid) {
    int dev = 0, cus = 0, per_cu = 0;
    hipGetDevice(&dev);
    hipDeviceGetAttribute(&cus, hipDeviceAttributeMultiprocessorCount, dev);
    hipOccupancyMaxActiveBlocksPerMultiprocessor(&per_cu, mega, 256, 0);
    if (per_cu < 1) per_cu = 1;
    if (per_cu > 2) per_cu = 2;
    grid = cus * per_cu;
    if (ws_size < WS_LIMIT + 16384) fprintf(stderr, "kernel_launch: ws too small (%zu)\n", ws_size);
  }
  Params p{};
  const float** pp = (const float**)&p;
  for (int i = 0; i < 27; ++i) pp[i] = (const float*)d_in[i];
  p.out = (float*)d_out;
  p.ws = (char*)d_ws;
#if MK_COOP
  hipMemsetAsync((char*)d_ws + OFF_MOD, 0, 2 * 5 * 3072 * 4 + XCD_BAR_WORDS * 4, stream);
  int lo = 0, hi = NPHASE;
  void* args[] = {&p, &lo, &hi};
  hipError_t e = hipLaunchCooperativeKernel((void*)mega, dim3(grid), dim3(256), args, 0, stream);
  if (e != hipSuccess) fprintf(stderr, "cooperative launch failed: %s (grid %d)\n", hipGetErrorString(e), grid);
#else
  for (int ph = 0; ph < NPHASE; ++ph) hipLaunchKernelGGL(mega, dim3(grid), dim3(256), 0, stream, p, ph, ph + 1);
#endif
}
```

```cpp
#include <hip/hip_runtime.h>
#include <hip/hip_cooperative_groups.h>
#include <cstdio>
namespace cg = cooperative_groups;

#ifndef PHMASK
#define PHMASK 0xFFF
#endif
#ifndef REPEAT_MASK
#define REPEAT_MASK 0
#endif
#ifndef MK_COOP
#define MK_COOP 1
#endif

#define DI __device__ __forceinline__
#define GLOBAL __attribute__((address_space(1)))
typedef unsigned short u16;
typedef unsigned int u32;
typedef __attribute__((ext_vector_type(8))) short bf16x8;
typedef __attribute__((ext_vector_type(4))) short s16x4;
typedef __attribute__((ext_vector_type(16))) float f32x16;
typedef __attribute__((ext_vector_type(4))) float f32x4;
typedef __attribute__((ext_vector_type(2))) float f32x2;
typedef __attribute__((ext_vector_type(4))) u32 u32x4;
typedef __attribute__((ext_vector_type(2))) u32 u32x2;

constexpr int TP = 8192, TS = 16384, T = 24576, NKS = 4608, KROWS = 26624;
constexpr float EPS = 1e-6f;
constexpr float LOG2E = 1.4426950408889634f;
constexpr int NPHASE = 12;
constexpr int SMEM_BYTES = 73728;

constexpr size_t OFF_WINE = 0;
constexpr size_t OFF_WOUTE = OFF_WINE + 2304ull * 1024 * 2;
constexpr size_t OFF_WINO = OFF_WOUTE + 1024ull * 1024 * 2;
constexpr size_t OFF_WOUTO = OFF_WINO + 3328ull * 1024 * 2;
constexpr size_t OFF_WUQ = OFF_WOUTO + 1024ull * 1024 * 2;
constexpr size_t OFF_WUKVG = OFF_WUQ + 768ull * 384 * 2;
constexpr size_t OFF_WUKV = OFF_WUKVG + 1024ull * 256 * 2;
constexpr size_t OFF_WBMAP = OFF_WUKV + 1024ull * 256 * 2;
constexpr size_t OFF_MOD = OFF_WBMAP + 4ull * 128 * 128 * 2;
constexpr size_t OFF_BAR = OFF_MOD + 2ull * 5 * 3072 * 4;
constexpr size_t OFF_ROPEA = OFF_BAR + 16384;
constexpr size_t OFF_ROPED = OFF_ROPEA + 2ull * 64 * 16 * 4;
constexpr size_t OFF_CKVCTX = OFF_ROPED + 2ull * 64 * 8 * 4;
constexpr size_t OFF_KPE = OFF_CKVCTX + 2048ull * 256 * 2;
constexpr size_t OFF_SSQ = OFF_KPE + 26624ull * 32 * 2;
constexpr size_t OFF_HU = OFF_SSQ + 24576ull * 16 * 4;
constexpr size_t OFF_R = OFF_HU + 24576ull * 1024 * 2;
constexpr size_t R_QA = OFF_R;
constexpr size_t R_GA = R_QA + (size_t)T * 512 * 2;
constexpr size_t R_GB = R_GA + (size_t)T * 512 * 2;
constexpr size_t R_UB = R_GB + (size_t)T * 512 * 2;
constexpr size_t R_KA = R_UB + (size_t)T * 512 * 2;
constexpr size_t R_VTAP = R_KA + (size_t)KROWS * 128 * 2;
constexpr size_t R_VTAS = R_VTAP + 32ull * 2 * 64 * 256 * 2;
constexpr size_t R_L0END = R_VTAS + 4ull * 2 * 64 * NKS * 2;
constexpr size_t R_Y = OFF_R;
constexpr size_t R_GD = OFF_R;
constexpr size_t R_CQ = R_GD + (size_t)T * 512 * 2;
constexpr size_t R_CKV = R_CQ + (size_t)T * 384 * 2;
constexpr size_t R_Z = R_CKV + (size_t)T * 256 * 2;
constexpr size_t R_QC = R_Z;
constexpr size_t R_GC = R_QC + (size_t)T * 512 * 2;
constexpr size_t R_KC = R_GC + (size_t)T * 512 * 2;
constexpr size_t R_VTCP = R_KC + (size_t)KROWS * 512 * 2;
constexpr size_t R_VTCS = R_VTCP + 32ull * 8 * 64 * 256 * 2;
constexpr size_t R_L1END_A = R_VTCS + 4ull * 8 * 64 * NKS * 2;
constexpr size_t R_QD = R_Z;
constexpr size_t R_KD = R_QD + (size_t)T * 768 * 2;
constexpr size_t R_VTDP = R_KD + (size_t)KROWS * 512 * 2;
constexpr size_t R_VTDS = R_VTDP + 32ull * 8 * 64 * 256 * 2;
constexpr size_t R_L1END_B = R_VTDS + 4ull * 8 * 64 * NKS * 2;
constexpr size_t WS_LIMIT = 256ull * 1024 * 1024 - 16384;
static_assert(R_L0END <= WS_LIMIT && R_L1END_A <= WS_LIMIT && R_L1END_B <= WS_LIMIT, "ws overflow");
static_assert(R_Y + (size_t)T * 1024 * 4 <= R_KA, "y aliasing");
static_assert(R_Y + (size_t)T * 1024 * 4 <= WS_LIMIT, "y fits");

constexpr size_t O_Y = 0;
constexpr size_t O_AK = 25165824;
constexpr size_t O_AV = O_AK + 1048576;
constexpr size_t O_CK = O_AV + 1048576;
constexpr size_t O_CV = O_CK + 4194304;
constexpr size_t O_CKV = O_CV + 4194304;
constexpr size_t O_KPE = O_CKV + 2097152;

struct Params {
  const float *x_prompt, *x_sample, *cache_a_k, *cache_a_v, *cache_c_k, *cache_c_v, *cache_d_ckv, *cache_d_kpe;
  const float *c, *c_ctx, *w_mod, *b_mod, *g_pre, *g_post, *w_in_e, *a_q_norm, *a_k_norm, *b_map, *b_scale, *w_out_e;
  const float *w_in_o, *c_rpb, *d_q_norm, *d_w_uq, *d_kv_norm, *d_w_ukv, *w_out_o;
  float* out;
  char* ws;
  int tid, bid;
};

DI u32 pack2(float a, float b) {
  typedef __attribute__((ext_vector_type(2))) __bf16 bf2;
  bf2 v;
  v[0] = (__bf16)a;
  v[1] = (__bf16)b;
  return __builtin_bit_cast(u32, v);
}
DI u16 f2bf(float a) { return __builtin_bit_cast(u16, (__bf16)a); }
DI float bf2f(u16 u) { return __uint_as_float(((u32)u) << 16); }
DI float bflo(u32 u) { return __uint_as_float(u << 16); }
DI float bfhi(u32 u) { return __uint_as_float(u & 0xffff0000u); }
DI float silu(float x) { return x * __builtin_amdgcn_rcpf(1.f + __builtin_amdgcn_exp2f(-1.4426950408889634f * x)); }
DI f32x16 mfma32(bf16x8 a, bf16x8 b, f32x16 c) { return __builtin_amdgcn_mfma_f32_32x32x16_bf16(a, b, c, 0, 0, 0); }
DI void unpack8(u32x4 u, float* f) {
  f[0] = bflo(u[0]); f[1] = bfhi(u[0]); f[2] = bflo(u[1]); f[3] = bfhi(u[1]);
  f[4] = bflo(u[2]); f[5] = bfhi(u[2]); f[6] = bflo(u[3]); f[7] = bfhi(u[3]);
}
DI u32x4 pack8(const float* f) {
  u32x4 u;
  u[0] = pack2(f[0], f[1]); u[1] = pack2(f[2], f[3]); u[2] = pack2(f[4], f[5]); u[3] = pack2(f[6], f[7]);
  return u;
}
DI void ld8(const float* p, float* v) {
  const f32x4 a = *(const f32x4*)p, b = *(const f32x4*)(p + 4);
  v[0] = a[0]; v[1] = a[1]; v[2] = a[2]; v[3] = a[3]; v[4] = b[0]; v[5] = b[1]; v[6] = b[2]; v[7] = b[3];
}
DI void st8(float* p, const float* v) {
  f32x4 a, b;
  a[0] = v[0]; a[1] = v[1]; a[2] = v[2]; a[3] = v[3]; b[0] = v[4]; b[1] = v[5]; b[2] = v[6]; b[3] = v[7];
  *(f32x4*)p = a; *(f32x4*)(p + 4) = b;
}
DI float xhalf_max(float x) {
  const auto r = __builtin_amdgcn_permlane32_swap(__float_as_uint(x), __float_as_uint(x), false, false);
  return fmaxf(__uint_as_float(r[0]), __uint_as_float(r[1]));
}
DI float xhalf_sum(float x) {
  const auto r = __builtin_amdgcn_permlane32_swap(__float_as_uint(x), __float_as_uint(x), false, false);
  return __uint_as_float(r[0]) + __uint_as_float(r[1]);
}
DI float red8(float v) {
  v += __shfl_xor(v, 1);
  v += __shfl_xor(v, 2);
  v += __shfl_xor(v, 4);
  return v;
}
DI float wave_sum(float v) {
  v += __shfl_xor(v, 1); v += __shfl_xor(v, 2); v += __shfl_xor(v, 4);
  v += __shfl_xor(v, 8); v += __shfl_xor(v, 16); v += __shfl_xor(v, 32);
  return v;
}

struct RowInfo { int samp, b, t, krow, key, nk, mrow; };
DI RowInfo row_info(int row) {
  RowInfo r;
  if (row < TP) { r.samp = 0; r.b = row >> 8; r.t = row & 255; r.krow = row; r.key = r.t; r.nk = 256; r.mrow = 0; }
  else { int q = row - TP; r.samp = 1; r.b = q >> 12; r.t = q & 4095; r.krow = TP + r.b * NKS + 512 + r.t; r.key = 512 + r.t; r.nk = NKS; r.mrow = 1 + r.b; }
  return r;
}

enum { EPI_EVEN = 0, EPI_Y = 1, EPI_ODD = 2, EPI_Q = 3, EPI_KV = 4, EPI_KVCTX = 5, EPI_POOL = 6 };
enum { AL_PLAIN = 0, AL_POOL = 1 };
constexpr int LROW = 144;
constexpr int TILEB = 128 * LROW;
constexpr int CSTR = 132;

struct GemmJob {
  const u16* A; int lda;
  const u16* Bt;
  int K;
  int grp;
};

template <int ALOAD>
DI u32x4 load_a_chunk(const GemmJob& j, int grow, int kofs) {
  if (ALOAD == AL_PLAIN) {
    return *(const u32x4*)(j.A + (size_t)grow * j.lda + kofs);
  } else {
    const int g = j.grp;
    const int w2 = 1 << g;
    int t, S;
    if (grow < TP) { t = grow & 255; S = 256; } else { t = (grow - TP) & 4095; S = 4096; }
    const int lo = max(t - w2, 0), hi = min(t + w2, S);
    const u16* base = j.A + (size_t)(grow - t) * 512 + g * 128 + kofs;
    float s[8];
#pragma unroll
    for (int e = 0; e < 8; ++e) s[e] = 0.f;
    for (int r = lo; r < hi; ++r) {
      u32x4 u = *(const u32x4*)(base + (size_t)r * 512);
      float f[8]; unpack8(u, f);
#pragma unroll
      for (int e = 0; e < 8; ++e) s[e] += f[e];
    }
    u32x4 u = *(const u32x4*)(base + (size_t)t * 512);
    float f[8]; unpack8(u, f);
    const float inv = 1.f / (float)(hi - lo);
#pragma unroll
    for (int e = 0; e < 8; ++e) s[e] = s[e] * inv - f[e];
    return pack8(s);
  }
}

template <int EPI>
DI void gemm_epilogue(const Params& p, const GemmJob& j, int m0, int n0, const float* Cs, int tid);

struct GemmPre { u32x4 ra[4], rb[4]; };
template <int EPI, int ALOAD>
DI void gemm_tile(const Params& p, const GemmJob& j, int m0, int n0, char* smem, GemmPre& pre, bool have_pre, int nm0, int nn0) {
  const int tid = p.tid, lane = tid & 63, wid = tid >> 6;
  const int wm = wid >> 1, wn = wid & 1, l31 = lane & 31, lh = lane >> 5;
  f32x16 acc[2][2];
#pragma unroll
  for (int a = 0; a < 2; ++a)
#pragma unroll
    for (int b = 0; b < 2; ++b)
#pragma unroll
      for (int i = 0; i < 16; ++i) acc[a][b][i] = 0.f;
  const int nk = j.K >> 6;
  u32x4 ra[4], rb[4];
#define G_LOAD_T(RA, RB, mm, nn, kt)                                                                 \
  {                                                                                                  \
    _Pragma("unroll") for (int i = 0; i < 4; ++i) {                                                  \
      const int row = tid >> 1, kc = (tid & 1) * 4 + i;                                              \
      RA[i] = load_a_chunk<ALOAD>(j, (mm) + row, (kt) * 64 + kc * 8);                                \
      RB[i] = *(const u32x4*)(j.Bt + (size_t)((nn) + row) * j.K + (kt) * 64 + kc * 8);               \
    }                                                                                                \
  }
#define G_LOAD(kt) G_LOAD_T(ra, rb, m0, n0, kt)
#define G_STORE(st)                                                                                  \
  {                                                                                                  \
    char* sa = smem + (st) * 2 * TILEB;                                                              \
    char* sb = sa + TILEB;                                                                           \
    _Pragma("unroll") for (int i = 0; i < 4; ++i) {                                                  \
      const int row = tid >> 1, kc = (tid & 1) * 4 + i;                                              \
      *(u32x4*)(sa + row * LROW + kc * 16) = ra[i];                                                  \
      *(u32x4*)(sb + row * LROW + kc * 16) = rb[i];                                                  \
    }                                                                                                \
  }
  if (have_pre) {
#pragma unroll
    for (int i = 0; i < 4; ++i) { ra[i] = pre.ra[i]; rb[i] = pre.rb[i]; }
  } else {
    G_LOAD(0);
  }
  G_STORE(0);
  if (nk > 1) G_LOAD(1);
  __syncthreads();
  for (int kt = 0; kt < nk; ++kt) {
    __builtin_amdgcn_sched_barrier(0);
    const char* sa = smem + (kt & 1) * 2 * TILEB;
    const char* sb = sa + TILEB;
    bf16x8 af[2][2], bfr[2][2];
#define LDFRAG(buf, kk)                                                                              \
  {                                                                                                  \
    _Pragma("unroll") for (int mt = 0; mt < 2; ++mt) af[buf][mt] = *(const bf16x8*)(sa + (wm * 64 + mt * 32 + l31) * LROW + (kk) * 32 + lh * 16); \
    _Pragma("unroll") for (int nt = 0; nt < 2; ++nt) bfr[buf][nt] = *(const bf16x8*)(sb + (wn * 64 + nt * 32 + l31) * LROW + (kk) * 32 + lh * 16); \
  }
    LDFRAG(0, 0);
#pragma unroll
    for (int kk = 0; kk < 4; ++kk) {
      if (kk < 3) LDFRAG((kk + 1) & 1, kk + 1);
      __builtin_amdgcn_sched_barrier(0);
#pragma unroll
      for (int mt = 0; mt < 2; ++mt)
#pragma unroll
        for (int nt = 0; nt < 2; ++nt) acc[mt][nt] = mfma32(af[kk & 1][mt], bfr[kk & 1][nt], acc[mt][nt]);
      __builtin_amdgcn_sched_barrier(0);
    }
#undef LDFRAG
    __builtin_amdgcn_sched_barrier(0);
    if (kt + 1 < nk) {
      G_STORE((kt + 1) & 1);
      if (kt + 2 < nk) G_LOAD(kt + 2);
    }
    __builtin_amdgcn_sched_barrier(0);
    __syncthreads();
  }
#undef G_STORE
  float* Cs = (float*)smem;
#pragma unroll
  for (int mt = 0; mt < 2; ++mt)
#pragma unroll
    for (int nt = 0; nt < 2; ++nt)
#pragma unroll
      for (int i = 0; i < 16; ++i) {
        const int row = wm * 64 + mt * 32 + (i & 3) + 8 * (i >> 2) + 4 * lh;
        const int col = wn * 64 + nt * 32 + l31;
        Cs[row * CSTR + col] = acc[mt][nt][i];
      }
  __syncthreads();
  if (nm0 >= 0) G_LOAD_T(pre.ra, pre.rb, nm0, nn0, 0);
  __builtin_amdgcn_sched_barrier(0);
  gemm_epilogue<EPI>(p, j, m0, n0, Cs, tid);
  __syncthreads();
#undef G_LOAD
#undef G_LOAD_T
}

DI void pool_tile(const Params& p, int m0, int g, char* smem) {
  const int tid = p.tid, lane = tid & 63, wid = tid >> 6;
  const int wm = wid >> 1, wn = wid & 1, l31 = lane & 31, lh = lane >> 5;
  const u16* Ub = (const u16*)(p.ws + R_UB);
  const u16* Bt = (const u16*)(p.ws + OFF_WBMAP) + (size_t)g * 128 * 128;
  const int w2 = 1 << g;
  const int row = tid >> 1, kcb = (tid & 1) * 4;
#pragma unroll
  for (int kt = 0; kt < 2; ++kt)
#pragma unroll
    for (int i = 0; i < 4; ++i)
      *(u32x4*)(smem + kt * 2 * TILEB + TILEB + row * LROW + (kcb + i) * 16) = *(const u32x4*)(Bt + (size_t)row * 128 + kt * 64 + (kcb + i) * 8);
  {
    const int grow = m0 + row;
    int t, S;
    if (grow < TP) { t = grow & 255; S = 256; } else { t = (grow - TP) & 4095; S = 4096; }
    const float inv = 1.f / (float)(min(t + w2, S) - max(t - w2, 0));
#pragma unroll 1
    for (int q = 0; q < 8; ++q) {
      const int kt = q >> 2, kc = kcb + (q & 3);
      const u16* base = Ub + (size_t)(grow - t) * 512 + g * 128 + kt * 64 + kc * 8;
      u32x4 u[16];
#pragma unroll
      for (int r = 0; r < 16; ++r)
        if (r < 2 * w2) {
          const int rc = min(max(t - w2 + r, 0), S - 1);
          u[r] = *(const u32x4*)(base + (size_t)rc * 512);
        }
      const u32x4 uo = *(const u32x4*)(base + (size_t)t * 512);
      float sacc[8];
#pragma unroll
      for (int e = 0; e < 8; ++e) sacc[e] = 0.f;
#pragma unroll
      for (int r = 0; r < 16; ++r)
        if (r < 2 * w2) {
          const int rr = t - w2 + r;
          const float ok = (rr >= 0 && rr < S) ? 1.f : 0.f;
          float x[8]; unpack8(u[r], x);
#pragma unroll
          for (int e = 0; e < 8; ++e) sacc[e] += ok * x[e];
        }
      float f[8]; unpack8(uo, f);
#pragma unroll
      for (int e = 0; e < 8; ++e) sacc[e] = sacc[e] * inv - f[e];
      *(u32x4*)(smem + kt * 2 * TILEB + row * LROW + kc * 16) = pack8(sacc);
    }
  }
  __syncthreads();
  f32x16 acc[2][2];
#pragma unroll
  for (int a = 0; a < 2; ++a)
#pragma unroll
    for (int b = 0; b < 2; ++b)
#pragma unroll
      for (int i = 0; i < 16; ++i) acc[a][b][i] = 0.f;
#pragma unroll
  for (int kt = 0; kt < 2; ++kt) {
    const char* sa = smem + kt * 2 * TILEB;
    const char* sb = sa + TILEB;
#pragma unroll
    for (int kk = 0; kk < 4; ++kk) {
      bf16x8 af[2], bfr[2];
#pragma unroll
      for (int mt = 0; mt < 2; ++mt) af[mt] = *(const bf16x8*)(sa + (wm * 64 + mt * 32 + l31) * LROW + kk * 32 + lh * 16);
#pragma unroll
      for (int nt = 0; nt < 2; ++nt) bfr[nt] = *(const bf16x8*)(sb + (wn * 64 + nt * 32 + l31) * LROW + kk * 32 + lh * 16);
#pragma unroll
      for (int mt = 0; mt < 2; ++mt)
#pragma unroll
        for (int nt = 0; nt < 2; ++nt) acc[mt][nt] = mfma32(af[mt], bfr[nt], acc[mt][nt]);
    }
  }
  __syncthreads();
  float* Cs = (float*)smem;
#pragma unroll
  for (int mt = 0; mt < 2; ++mt)
#pragma unroll
    for (int nt = 0; nt < 2; ++nt)
#pragma unroll
      for (int i = 0; i < 16; ++i) {
        const int r2 = wm * 64 + mt * 32 + (i & 3) + 8 * (i >> 2) + 4 * lh;
        const int c2 = wn * 64 + nt * 32 + l31;
        Cs[r2 * CSTR + c2] = acc[mt][nt][i];
      }
  __syncthreads();
  GemmJob j; j.A = nullptr; j.lda = 0; j.Bt = nullptr; j.K = 128; j.grp = g;
  gemm_epilogue<EPI_POOL>(p, j, m0, 0, Cs, tid);
  __syncthreads();
}

DI void store_vt_tile(const float* Cs, int m0, int tid, u16* vtP, u16* vtS, int nheads, int head0, const float* rowscale_ssq, int ssq_ofs, int ssq_n, float ssq_div, bool ctx_rows) {
  const int r = tid & 127, half = tid >> 7;
  int b, key, nk; u16* base;
  if (ctx_rows) {
    const int i = m0 + r; b = i >> 9; key = i & 511; nk = NKS; base = vtS;
  } else {
    RowInfo ri = row_info(m0 + r); b = ri.b; key = ri.key; nk = ri.nk; base = ri.samp ? vtS : vtP;
  }
  float rs = 1.f;
  if (rowscale_ssq) {
    float s = 0.f;
    for (int q = 0; q < ssq_n; ++q) s += rowscale_ssq[(size_t)(m0 + r) * 16 + ssq_ofs + q];
    rs = rsqrtf(s / ssq_div + EPS);
  }
  const int head = head0 + half;
  u16* dst = base + ((size_t)(b * nheads + head) * 64) * nk + key;
#pragma unroll 4
  for (int j4 = 0; j4 < 16; ++j4) {
    f32x4 f = *(const f32x4*)(Cs + r * CSTR + half * 64 + j4 * 4);
#pragma unroll
    for (int e = 0; e < 4; ++e) dst[(size_t)(j4 * 4 + e) * nk] = f2bf(f[e] * rs);
  }
}

template <int EPI>
DI void gemm_epilogue(const Params& p, const GemmJob& j, int m0, int n0, const float* Cs, int tid) {
  char* ws = p.ws;
  const int ntile = n0 >> 7;
  if (EPI == EPI_Y) {
    u16* y = (u16*)(ws + R_Y);
#pragma unroll
    for (int it = 0; it < 8; ++it) {
      const int item = it * 256 + tid, row = item >> 4, col0 = (item & 15) * 8;
      float v[8];
      ld8(Cs + row * CSTR + col0, v);
      *(u32x4*)(y + (size_t)(m0 + row) * 1024 + n0 + col0) = pack8(v);
    }
    return;
  }
  if (EPI == EPI_POOL) {
    const int g = j.grp;
    const u16* Gb = (const u16*)(ws + R_GB);
    u16* U = (u16*)(ws + OFF_HU);
    float bs[8];
    {
      const int gc0 = g * 128 + (tid & 15) * 8;
#pragma unroll
      for (int e = 0; e < 8; ++e) bs[e] = p.b_scale[gc0 + e];
    }
#pragma unroll
    for (int it = 0; it < 8; ++it) {
      const int item = it * 256 + tid, row = item >> 4, col0 = (item & 15) * 8;
      const int grow = m0 + row, gc = g * 128 + col0;
      float v[8], gt[8];
      ld8(Cs + row * CSTR + col0, v);
      unpack8(*(const u32x4*)(Gb + (size_t)grow * 512 + gc), gt);
#pragma unroll
      for (int e = 0; e < 8; ++e) v[e] = v[e] * bs[e] * gt[e];
      *(u32x4*)(U + (size_t)grow * 1024 + 512 + gc) = pack8(v);
    }
    return;
  }
  if (EPI == EPI_EVEN) {
    if (ntile == 5) {
#pragma unroll
      for (int it = 0; it < 8; ++it) {
        const int item = it * 256 + tid, row = item >> 4, col0 = (item & 15) * 8;
        const int grow = m0 + row;
        if (grow < TP) {
          float* d = p.out + O_AV + (size_t)grow * 128 + col0;
          *(f32x4*)d = *(const f32x4*)(Cs + row * CSTR + col0); *(f32x4*)(d + 4) = *(const f32x4*)(Cs + row * CSTR + col0 + 4);
        }
      }
      store_vt_tile(Cs, m0, tid, (u16*)(ws + R_VTAP), (u16*)(ws + R_VTAS), 2, 0, nullptr, 0, 0, 1.f, false);
      return;
    }
    const float* ropec = (const float*)(ws + OFF_ROPEA);
    const float* ropes = ropec + 64 * 16;
    float gnv[8], gpv[8];
    {
      const float* gn0 = (ntile < 4) ? p.a_q_norm : p.a_k_norm;
      const int d0c = (n0 + (tid & 15) * 8) & 63;
#pragma unroll
      for (int e = 0; e < 8; ++e) { gnv[e] = (ntile <= 4) ? gn0[d0c + e] : 0.f; gpv[e] = (ntile <= 4) ? gn0[(d0c ^ 16) + e] : 0.f; }
    }
#pragma unroll
    for (int it = 0; it < 8; ++it) {
      const int item = it * 256 + tid, row = item >> 4, col0 = (item & 15) * 8;
      const int grow = m0 + row, gcol = n0 + col0;
      float v[8];
      ld8(Cs + row * CSTR + col0, v);
      if (ntile <= 4) {
        const bool isq = ntile < 4;
        const RowInfo ri = row_info(grow);
        const int d0 = gcol & 63;
        float ss = 0.f;
#pragma unroll
        for (int e = 0; e < 8; ++e) ss += v[e] * v[e];
        ss = red8(ss);
        const float r = rsqrtf(ss * (1.f / 64.f) + EPS);
        float nv[8];
#pragma unroll
        for (int e = 0; e < 8; ++e) nv[e] = v[e] * r * gnv[e];
        if (!isq && !ri.samp) {
          float* d = p.out + O_AK + (size_t)grow * 128 + (gcol - 512);
          st8(d, nv);
        }
        if (ri.samp) {
          const int pc = col0 ^ 16, pd0 = d0 ^ 16;
          float pv[8];
          ld8(Cs + row * CSTR + pc, pv);
          const int pos = (d0 < 32) ? (ri.t >> 6) : (ri.t & 63);
          const int i0 = d0 & 15;
          const float sgn = (d0 & 16) ? 1.f : -1.f;
#pragma unroll
          for (int e = 0; e < 8; ++e) {
            const float pn = pv[e] * r * gpv[e];
            const float cs = ropec[pos * 16 + i0 + e], sn = ropes[pos * 16 + i0 + e];
            nv[e] = nv[e] * cs + sgn * pn * sn;
          }
        }
        if (isq) *(u32x4*)((u16*)(ws + R_QA) + (size_t)grow * 512 + gcol) = pack8(nv);
        else *(u32x4*)((u16*)(ws + R_KA) + (size_t)ri.krow * 128 + (gcol - 512)) = pack8(nv);
      } else if (ntile < 10) {
#pragma unroll
        for (int e = 0; e < 8; ++e) v[e] = silu(v[e]);
        *(u32x4*)((u16*)(ws + R_GA) + (size_t)grow * 512 + (gcol - 768)) = pack8(v);
      } else if (ntile < 14) {
        *(u32x4*)((u16*)(ws + R_UB) + (size_t)grow * 512 + (gcol - 1280)) = pack8(v);
      } else {
#pragma unroll
        for (int e = 0; e < 8; ++e) v[e] = silu(v[e]);
        *(u32x4*)((u16*)(ws + R_GB) + (size_t)grow * 512 + (gcol - 1792)) = pack8(v);
      }
    }
    return;
  }
  if (EPI == EPI_ODD) {
    if (ntile >= 8 && ntile < 12) {
#pragma unroll
      for (int it = 0; it < 8; ++it) {
        const int item = it * 256 + tid, row = item >> 4, col0 = (item & 15) * 8;
        const int grow = m0 + row;
        if (grow < TP) {
          float* d = p.out + O_CV + (size_t)grow * 512 + (n0 - 1024) + col0;
          *(f32x4*)d = *(const f32x4*)(Cs + row * CSTR + col0); *(f32x4*)(d + 4) = *(const f32x4*)(Cs + row * CSTR + col0 + 4);
        }
      }
      store_vt_tile(Cs, m0, tid, (u16*)(ws + R_VTCP), (u16*)(ws + R_VTCS), 8, (n0 - 1024) >> 6, nullptr, 0, 0, 1.f, false);
      return;
    }
    const float* ropec = (const float*)(ws + OFF_ROPED);
    const float* ropes = ropec + 64 * 8;
    float* ssq = (float*)(ws + OFF_SSQ);
#pragma unroll
    for (int it = 0; it < 8; ++it) {
      const int item = it * 256 + tid, row = item >> 4, c8 = item & 15, col0 = c8 * 8;
      const int grow = m0 + row, gcol = n0 + col0;
      float v[8];
      ld8(Cs + row * CSTR + col0, v);
      if (ntile < 4) {
        *(u32x4*)((u16*)(ws + R_QC) + (size_t)grow * 512 + gcol) = pack8(v);
      } else if (ntile < 8) {
        const RowInfo ri = row_info(grow);
        if (!ri.samp) { float* d = p.out + O_CK + (size_t)grow * 512 + (gcol - 512); st8(d, v); }
        *(u32x4*)((u16*)(ws + R_KC) + (size_t)ri.krow * 512 + (gcol - 512)) = pack8(v);
      } else if (ntile < 16) {
#pragma unroll
        for (int e = 0; e < 8; ++e) v[e] = silu(v[e]);
        *(u32x4*)((u16*)(ws + R_GC) + (size_t)grow * 512 + (gcol - 1536)) = pack8(v);
      } else if (ntile < 20) {
#pragma unroll
        for (int e = 0; e < 8; ++e) v[e] = silu(v[e]);
        *(u32x4*)((u16*)(ws + R_GD) + (size_t)grow * 512 + (gcol - 2048)) = pack8(v);
      } else if (ntile < 23) {
        float ss = 0.f;
#pragma unroll
        for (int e = 0; e < 8; ++e) ss += v[e] * v[e];
        ss = red8(ss);
        if ((c8 & 7) == 0) ssq[(size_t)grow * 16 + ((gcol - 2560) >> 6)] = ss;
        *(u32x4*)((u16*)(ws + R_CQ) + (size_t)grow * 384 + (gcol - 2560)) = pack8(v);
      } else if (ntile < 25) {
        float ss = 0.f;
#pragma unroll
        for (int e = 0; e < 8; ++e) ss += v[e] * v[e];
        ss = red8(ss);
        if ((c8 & 7) == 0) ssq[(size_t)grow * 16 + 8 + ((gcol - 2944) >> 6)] = ss;
        *(u32x4*)((u16*)(ws + R_CKV) + (size_t)grow * 256 + (gcol - 2944)) = pack8(v);
        if (grow < TP) { float* d = p.out + O_CKV + (size_t)grow * 256 + (gcol - 2944); st8(d, v); }
      } else {
        if (c8 < 4) {
          const RowInfo ri = row_info(grow);
          const int d0 = col0;
          if (!ri.samp) { float* d = p.out + O_KPE + (size_t)grow * 32 + d0; st8(d, v); }
          else {
            const int pc = col0 ^ 8;
            float pv[8];
            ld8(Cs + row * CSTR + pc, pv);
            const int pos = (d0 < 16) ? (ri.t >> 6) : (ri.t & 63);
            const float sgn = (d0 & 8) ? 1.f : -1.f;
#pragma unroll
            for (int e = 0; e < 8; ++e) {
              const float cs = ropec[pos * 8 + e], sn = ropes[pos * 8 + e];
              v[e] = v[e] * cs + sgn * pv[e] * sn;
            }
          }
          *(u32x4*)((u16*)(ws + OFF_KPE) + (size_t)ri.krow * 32 + d0) = pack8(v);
        }
      }
    }
    return;
  }
  if (EPI == EPI_Q) {
    const float* ropec = (const float*)(ws + OFF_ROPED);
    const float* ropes = ropec + 64 * 8;
    const float* ssq = (const float*)(ws + OFF_SSQ);
    u16* Qd = (u16*)(ws + R_QD);
#pragma unroll
    for (int it = 0; it < 8; ++it) {
      const int item = it * 256 + tid, row = item >> 4, col0 = (item & 15) * 8;
      const int grow = m0 + row, gcol = n0 + col0;
      float s = 0.f;
#pragma unroll
      for (int q = 0; q < 6; ++q) s += ssq[(size_t)grow * 16 + q];
      const float r = rsqrtf(s * (1.f / 384.f) + EPS);
      float v[8];
      ld8(Cs + row * CSTR + col0, v);
#pragma unroll
      for (int e = 0; e < 8; ++e) v[e] *= r;
      if (gcol < 512) {
        const int head = gcol >> 6, d = gcol & 63;
        *(u32x4*)(Qd + (size_t)grow * 768 + head * 96 + d) = pack8(v);
      } else {
        const int m = gcol - 512, head = m >> 5, d0 = m & 31;
        const RowInfo ri = row_info(grow);
        if (ri.samp) {
          const int pc = col0 ^ 8;
          float pv[8];
          ld8(Cs + row * CSTR + pc, pv);
          const int pos = (d0 < 16) ? (ri.t >> 6) : (ri.t & 63);
          const float sgn = (d0 & 8) ? 1.f : -1.f;
#pragma unroll
          for (int e = 0; e < 8; ++e) {
            const float cs = ropec[pos * 8 + e], sn = ropes[pos * 8 + e];
            v[e] = v[e] * cs + sgn * (pv[e] * r) * sn;
          }
        }
        *(u32x4*)(Qd + (size_t)grow * 768 + head * 96 + 64 + d0) = pack8(v);
      }
    }
    return;
  }
  if (EPI == EPI_KV || EPI == EPI_KVCTX) {
    const float* ssq = (const float*)(ws + OFF_SSQ);
    if (n0 >= 512) {
      store_vt_tile(Cs, m0, tid, (u16*)(ws + R_VTDP), (u16*)(ws + R_VTDS), 8, (n0 - 512) >> 6,
                    EPI == EPI_KV ? ssq : nullptr, 8, 4, 256.f, EPI == EPI_KVCTX);
      return;
    }
    u16* Kd = (u16*)(ws + R_KD);
#pragma unroll
    for (int it = 0; it < 8; ++it) {
      const int item = it * 256 + tid, row = item >> 4, col0 = (item & 15) * 8;
      const int grow = m0 + row, gcol = n0 + col0;
      float r = 1.f; int krow;
      if (EPI == EPI_KV) {
        float s = 0.f;
#pragma unroll
        for (int q = 0; q < 4; ++q) s += ssq[(size_t)grow * 16 + 8 + q];
        r = rsqrtf(s * (1.f / 256.f) + EPS);
        krow = row_info(grow).krow;
      } else {
        krow = TP + (grow >> 9) * NKS + (grow & 511);
      }
      float v[8];
      ld8(Cs + row * CSTR + col0, v);
#pragma unroll
      for (int e = 0; e < 8; ++e) v[e] *= r;
      *(u32x4*)(Kd + (size_t)krow * 512 + gcol) = pack8(v);
    }
    return;
  }
}

struct AttnJob {
  const u16* Q; int q_stride;
  const u16* K; int k_stride;
  const u16* K2;
  const u16* Vt; int nk;
  const u16* G;
  u16* U;
  int qrow0;
  int ntiles;
  float sc;
  int qt2; const float* rpb;
  int tid;
};

constexpr int VROW = 136;
template <int DK>
struct AttnCfg { static constexpr int KROW = DK * 2 + 16; static constexpr int STAGE = 64 * (KROW + VROW); static constexpr int KCH = DK / 8; static constexpr int NKL = (64 * KCH) / 256; };
constexpr int RPB_OFF = 45056;

template <int DK, bool NA>
DI void attn_item(const AttnJob& j, char* smem) {
  typedef AttnCfg<DK> C;
  const int tid = j.tid, lane = tid & 63, wid = tid >> 6, l31 = lane & 31, lh = lane >> 5;
  int r0e = 0;
  float* rpbl = (float*)(smem + RPB_OFF);
  if (NA) {
    r0e = min(max(2 * j.qt2 - 4, 0), 56);
    for (int i = tid; i < 465; i += 256) rpbl[i] = j.rpb[i] * LOG2E;
  }
  bf16x8 qf[DK / 16];
  {
    const u16* qp = j.Q + (size_t)(j.qrow0 + wid * 32 + l31) * j.q_stride + lh * 8;
#pragma unroll
    for (int kk = 0; kk < DK / 16; ++kk) qf[kk] = *(const bf16x8*)(qp + kk * 16);
  }
  f32x16 o[2];
#pragma unroll
  for (int a = 0; a < 2; ++a)
#pragma unroll
    for (int i = 0; i < 16; ++i) o[a][i] = 0.f;
  float m_run = -INFINITY, l_run = 0.f;
  u32x4 rk[C::NKL], rv[2];
#define KEY0(jt) (NA ? ((jt) < 8 ? (jt) * 64 : 512 + (r0e + (jt) - 8) * 64) : (jt) * 64)
#define A_LOAD(jt)                                                                                   \
  {                                                                                                  \
    const int key0 = KEY0(jt);                                                                       \
    _Pragma("unroll") for (int i = 0; i < C::NKL; ++i) {                                             \
      const int c = tid + 256 * i, row = c / C::KCH, ch = c % C::KCH;                                \
      if (DK == 96 && ch >= 8) rk[i] = *(const u32x4*)(j.K2 + (size_t)(key0 + row) * 32 + (ch - 8) * 8); \
      else rk[i] = *(const u32x4*)(j.K + (size_t)(key0 + row) * j.k_stride + ch * 8);                \
    }                                                                                                \
    _Pragma("unroll") for (int i = 0; i < 2; ++i) {                                                  \
      const int c = tid + 256 * i, row = c >> 3, ch = c & 7;                                         \
      rv[i] = *(const u32x4*)(j.Vt + (size_t)row * j.nk + key0 + ch * 8);                            \
    }                                                                                                \
  }
#define A_STORE(st)                                                                                  \
  {                                                                                                  \
    char* sk = smem + (st) * C::STAGE;                                                               \
    char* sv = sk + 64 * C::KROW;                                                                    \
    _Pragma("unroll") for (int i = 0; i < C::NKL; ++i) {                                             \
      const int c = tid + 256 * i, row = c / C::KCH, ch = c % C::KCH;                                \
      *(u32x4*)(sk + row * C::KROW + ch * 16) = rk[i];                                               \
    }                                                                                                \
    _Pragma("unroll") for (int i = 0; i < 2; ++i) {                                                  \
      const int c = tid + 256 * i, row = c >> 3, ch = c & 7;                                         \
      u32x2 lo, hi; lo[0] = rv[i][0]; lo[1] = rv[i][1]; hi[0] = rv[i][2]; hi[1] = rv[i][3];          \
      *(u32x2*)(sv + row * VROW + ch * 16) = lo;                                                     \
      *(u32x2*)(sv + row * VROW + ch * 16 + 8) = hi;                                                 \
    }                                                                                                \
  }
  A_LOAD(0);
  A_STORE(0);
  __syncthreads();
  const int qr = 2 * j.qt2 + (wid >> 1), qc = (wid & 1) * 32 + l31;
  const int r0 = min(max(qr - 4, 0), 56), c0 = min(max(qc - 8, 0), 48);
  for (int jt = 0; jt < j.ntiles; ++jt) {
    if (jt + 1 < j.ntiles) A_LOAD(jt + 1);
    __builtin_amdgcn_sched_barrier(0);
    const char* sk = smem + (jt & 1) * C::STAGE;
    const char* sv = sk + 64 * C::KROW;
    bool skip_tile = false;
    if (NA && jt >= 8) { const int kr_ = r0e + jt - 8; skip_tile = !((kr_ >= r0) && (kr_ < r0 + 8)); }
    if (!skip_tile) {
    f32x16 s[2];
#pragma unroll
    for (int a = 0; a < 2; ++a)
#pragma unroll
      for (int i = 0; i < 16; ++i) s[a][i] = 0.f;
    {
      bf16x8 kf[2][2];
#define LDK(buf, kk) { _Pragma("unroll") for (int mt = 0; mt < 2; ++mt) kf[buf][mt] = *(const bf16x8*)(sk + (mt * 32 + l31) * C::KROW + (kk) * 32 + lh * 16); }
      LDK(0, 0);
      __builtin_amdgcn_s_setprio(1);
#pragma unroll
      for (int kk = 0; kk < DK / 16; ++kk) {
        if (kk + 1 < DK / 16) LDK((kk + 1) & 1, kk + 1);
        __builtin_amdgcn_sched_barrier(0);
#pragma unroll
        for (int mt = 0; mt < 2; ++mt) s[mt] = mfma32(kf[kk & 1][mt], qf[kk], s[mt]);
        __builtin_amdgcn_sched_barrier(0);
      }
      __builtin_amdgcn_s_setprio(0);
#undef LDK
    }
    u32x4 vfr[2][2];
#define LDV(buf, sp)                                                                                 \
  {                                                                                                  \
    _Pragma("unroll") for (int dt = 0; dt < 2; ++dt) {                                               \
      const char* vp = sv + (dt * 32 + l31) * VROW + (16 * (sp) + 4 * lh) * 2;                       \
      const u32x2 lo = *(const u32x2*)vp, hi = *(const u32x2*)(vp + 16);                             \
      vfr[buf][dt][0] = lo[0]; vfr[buf][dt][1] = lo[1]; vfr[buf][dt][2] = hi[0]; vfr[buf][dt][3] = hi[1]; \
    }                                                                                                \
  }
    LDV(0, 0);
    __builtin_amdgcn_sched_barrier(0);
    float mxs;
    if (NA && jt >= 8) {
      const int kr = r0e + jt - 8;
      const bool rowok = (kr >= r0) && (kr < r0 + 8);
      const float* bl = rpbl + (kr - qr + 7) * 31 + (15 - qc);
      float mx = -INFINITY;
#pragma unroll
      for (int mt = 0; mt < 2; ++mt)
#pragma unroll
        for (int i = 0; i < 16; ++i) {
          const int kc = 32 * mt + (i & 3) + 8 * (i >> 2) + 4 * lh;
          const bool ok = rowok && (kc >= c0) && (kc < c0 + 16);
          float bias = 0.f;
          if (ok) bias = bl[kc];
          const float t = ok ? (s[mt][i] * j.sc + bias) : -INFINITY;
          s[mt][i] = t;
          mx = fmaxf(mx, t);
        }
      mxs = xhalf_max(mx);
    } else {
      float mx = -INFINITY;
#pragma unroll
      for (int mt = 0; mt < 2; ++mt)
#pragma unroll
        for (int i = 0; i < 16; ++i) mx = fmaxf(mx, s[mt][i]);
      mx = xhalf_max(mx);
      mxs = mx * j.sc;
    }
    if (__any(mxs > m_run + 8.f)) {
      const float m_new = fmaxf(m_run, mxs);
      const float alpha = __builtin_amdgcn_exp2f(m_run - m_new);
      m_run = m_new;
      l_run *= alpha;
      const f32x2 a2 = {alpha, alpha};
#pragma unroll
      for (int a = 0; a < 2; ++a)
#pragma unroll
        for (int i = 0; i < 8; ++i) {
          f32x2 v = {o[a][2 * i], o[a][2 * i + 1]};
          v = v * a2;
          o[a][2 * i] = v[0]; o[a][2 * i + 1] = v[1];
        }
    }
    {
      f32x2 ps2 = {0.f, 0.f};
      const f32x2 nm2 = {-m_run, -m_run};
      const bool raw = !(NA && jt >= 8);
      const float scl = raw ? j.sc : 1.f;
      const f32x2 sc2 = {scl, scl};
#pragma unroll
      for (int mt = 0; mt < 2; ++mt)
#pragma unroll
        for (int i = 0; i < 8; ++i) {
          f32x2 v = {s[mt][2 * i], s[mt][2 * i + 1]};
          v = v * sc2 + nm2;
          f32x2 e = {__builtin_amdgcn_exp2f(v[0]), __builtin_amdgcn_exp2f(v[1])};
          s[mt][2 * i] = e[0]; s[mt][2 * i + 1] = e[1];
          ps2 += e;
        }
      l_run += ps2[0] + ps2[1];
    }
    __builtin_amdgcn_s_setprio(1);
#pragma unroll
    for (int sp = 0; sp < 4; ++sp) {
      const int mt = sp >> 1, s8 = (sp & 1) * 8;
      u32x4 pu;
      pu[0] = pack2(s[mt][s8 + 0], s[mt][s8 + 1]); pu[1] = pack2(s[mt][s8 + 2], s[mt][s8 + 3]);
      pu[2] = pack2(s[mt][s8 + 4], s[mt][s8 + 5]); pu[3] = pack2(s[mt][s8 + 6], s[mt][s8 + 7]);
      const bf16x8 pb = __builtin_bit_cast(bf16x8, pu);
      if (sp + 1 < 4) LDV((sp + 1) & 1, sp + 1);
      __builtin_amdgcn_sched_barrier(0);
#pragma unroll
      for (int dt = 0; dt < 2; ++dt) o[dt] = mfma32(__builtin_bit_cast(bf16x8, vfr[sp & 1][dt]), pb, o[dt]);
      __builtin_amdgcn_sched_barrier(0);
    }
    __builtin_amdgcn_s_setprio(0);
#undef LDV
    }
    __builtin_amdgcn_sched_barrier(0);
    if (jt + 1 < j.ntiles) A_STORE((jt + 1) & 1);
    __syncthreads();
  }
#undef A_LOAD
#undef A_STORE
#undef KEY0
  const float lt = xhalf_sum(l_run);
  const float inv = 1.f / lt;
  const int qrow = j.qrow0 + wid * 32 + l31;
  const u16* gp = j.G + (size_t)qrow * 512;
  u16* up = j.U + (size_t)qrow * 1024;
#pragma unroll
  for (int dt = 0; dt < 2; ++dt)
#pragma unroll
    for (int g4 = 0; g4 < 4; ++g4) {
      const int d = dt * 32 + 8 * g4 + 4 * lh;
      u32x2 gg = *(const u32x2*)(gp + d);
      u32x2 ov;
      ov[0] = pack2(o[dt][g4 * 4 + 0] * inv * bflo(gg[0]), o[dt][g4 * 4 + 1] * inv * bfhi(gg[0]));
      ov[1] = pack2(o[dt][g4 * 4 + 2] * inv * bflo(gg[1]), o[dt][g4 * 4 + 3] * inv * bfhi(gg[1]));
      *(u32x2*)(up + d) = ov;
    }
}

DI int perm_src(int perm, int n) {
  switch (perm) {
    case 0: return n;
    case 1:
      if (n < 2048) return n;
      if (n < 2560) return 2720 + (n - 2048);
      if (n < 2944) return 2048 + (n - 2560);
      if (n < 3200) return 2432 + (n - 2944);
      if (n < 3232) return 2688 + (n - 3200);
      return -1;
    case 2:
      if (n < 512) return (n >> 6) * 96 + (n & 63);
      return ((n - 512) >> 5) * 96 + 64 + ((n - 512) & 31);
    default:
      if (n < 512) return (n >> 6) * 128 + (n & 63);
      return ((n - 512) >> 6) * 128 + 64 + ((n - 512) & 63);
  }
}

DI void transpose_tile(const float* src, const float* g, u16* dst, int K, int Nsrc, int perm, int k0, int n0, char* smem, int tid) {
  float* tile = (float*)smem;
  {
    const int nn = tid & 63, kq = tid >> 6;
    const int sc = perm_src(perm, n0 + nn);
    float tv[16];
#pragma unroll
    for (int i = 0; i < 16; ++i) {
      const int k = kq + 4 * i;
      tv[i] = (sc >= 0) ? __builtin_nontemporal_load(&src[(size_t)(k0 + k) * Nsrc + sc]) : 0.f;
    }
#pragma unroll
    for (int i = 0; i < 16; ++i) {
      const int k = kq + 4 * i;
      float v = tv[i];
      if (g) v *= g[k0 + k];
      tile[k * 65 + nn] = v;
    }
  }
  __syncthreads();
  {
    const int kp = tid & 31, nb = tid >> 5;
#pragma unroll
    for (int i = 0; i < 8; ++i) {
      const int n = nb + 8 * i;
      const u32 v = pack2(tile[(2 * kp) * 65 + n], tile[(2 * kp + 1) * 65 + n]);
      *(u32*)(dst + (size_t)(n0 + n) * K + k0 + 2 * kp) = v;
    }
  }
  __syncthreads();
}

DI void mod_item(const Params& p, int item, char* smem) {
  const int ke = item & 7, cchunk = (item >> 3) % 48, layer = item / 384;
  const int c0 = cchunk * 64, k0 = ke * 128;
  float* sl = (float*)smem;
  float* red = sl + 5 * 128;
  const int tid = p.tid;
  for (int i = tid; i < 5 * 128; i += 256) {
    const int r = i >> 7, k = k0 + (i & 127);
    const float c = (r == 0) ? p.c_ctx[k] : p.c[(r - 1) * 1024 + k];
    sl[i] = silu(c);
  }
  __syncthreads();
  const int col = tid & 63, kw = tid >> 6;
  float acc[5] = {0.f, 0.f, 0.f, 0.f, 0.f};
  const float* w = p.w_mod + ((size_t)layer * 1024 + k0 + kw * 32) * 3072 + c0 + col;
#pragma unroll
  for (int k = 0; k < 32; ++k) {
    const float wv = __builtin_nontemporal_load(&w[(size_t)k * 3072]);
#pragma unroll
    for (int r = 0; r < 5; ++r) acc[r] += sl[r * 128 + kw * 32 + k] * wv;
  }
#pragma unroll
  for (int r = 0; r < 5; ++r) red[(kw * 5 + r) * 64 + col] = acc[r];
  __syncthreads();
  for (int i = tid; i < 5 * 64; i += 256) {
    const int r = i >> 6, cc = i & 63;
    float s = red[(0 * 5 + r) * 64 + cc] + red[(1 * 5 + r) * 64 + cc] + red[(2 * 5 + r) * 64 + cc] + red[(3 * 5 + r) * 64 + cc];
    if (ke == 0) s += p.b_mod[layer * 3072 + c0 + cc];
    atomicAdd((float*)(p.ws + OFF_MOD) + (layer * 5 + r) * 3072 + c0 + cc, s);
  }
  __syncthreads();
}

DI void phase0(const Params& p, char* smem) {
  char* ws = p.ws;
  const int NTR = 576 + 256 + 832 + 256 + 72 + 64 + 64 + 16;
  for (int item = p.bid; item < NTR + 768; item += gridDim.x) {
    if (item >= NTR) {
      mod_item(p, item - NTR, smem);
      continue;
    }
    int it = item;
    const float* src; const float* g = nullptr; u16* dst; int K, Nsrc, perm, tn;
    if (it < 576) { src = p.w_in_e; dst = (u16*)(ws + OFF_WINE); K = 1024; Nsrc = 2304; perm = 0; tn = 36; }
    else if ((it -= 576) < 256) { src = p.w_out_e; dst = (u16*)(ws + OFF_WOUTE); K = 1024; Nsrc = 1024; perm = 0; tn = 16; }
    else if ((it -= 256) < 832) { src = p.w_in_o; dst = (u16*)(ws + OFF_WINO); K = 1024; Nsrc = 3232; perm = 1; tn = 52; }
    else if ((it -= 832) < 256) { src = p.w_out_o; dst = (u16*)(ws + OFF_WOUTO); K = 1024; Nsrc = 1024; perm = 0; tn = 16; }
    else if ((it -= 256) < 72) { src = p.d_w_uq; g = p.d_q_norm; dst = (u16*)(ws + OFF_WUQ); K = 384; Nsrc = 768; perm = 2; tn = 12; }
    else if ((it -= 72) < 64) { src = p.d_w_ukv; g = p.d_kv_norm; dst = (u16*)(ws + OFF_WUKVG); K = 256; Nsrc = 1024; perm = 3; tn = 16; }
    else if ((it -= 64) < 64) { src = p.d_w_ukv; dst = (u16*)(ws + OFF_WUKV); K = 256; Nsrc = 1024; perm = 3; tn = 16; }
    else { it -= 64; const int gq = it >> 2; it &= 3; src = p.b_map + (size_t)gq * 128 * 128; dst = (u16*)(ws + OFF_WBMAP) + (size_t)gq * 128 * 128; K = 128; Nsrc = 128; perm = 0; tn = 2; }
    transpose_tile(src, g, dst, K, Nsrc, perm, (it / tn) * 64, (it % tn) * 64, smem, p.tid);
  }
  const int gt = p.bid * 256 + p.tid, gs = gridDim.x * 256;
  for (int i = gt; i < 64 * 16 + 64 * 8; i += gs) {
    if (i < 1024) {
      const int pos = i >> 4, f = i & 15;
      const float inv = powf(10000.f, -(float)(2 * f) / 32.f);
      const float ang = (float)pos * inv;
      ((float*)(ws + OFF_ROPEA))[i] = cosf(ang);
      ((float*)(ws + OFF_ROPEA))[1024 + i] = sinf(ang);
    } else {
      const int q = i - 1024, pos = q >> 3, f = q & 7;
      const float inv = powf(10000.f, -(float)(2 * f) / 16.f);
      const float ang = (float)pos * inv;
      ((float*)(ws + OFF_ROPED))[q] = cosf(ang);
      ((float*)(ws + OFF_ROPED))[512 + q] = sinf(ang);
    }
  }
  for (int i = gt; i < 4 * 512 * 128; i += gs) {
    const int b = i >> 16, n = (i >> 7) & 511, cc = i & 127;
    ((u16*)(ws + R_KA))[(size_t)(TP + b * NKS + n) * 128 + cc] = f2bf(p.cache_a_k[i]);
    const int kvh = cc >> 6, d = cc & 63;
    ((u16*)(ws + R_VTAS))[((size_t)(b * 2 + kvh) * 64 + d) * NKS + n] = f2bf(p.cache_a_v[i]);
  }
  for (int i = gt; i < 2048 * 256; i += gs) ((u16*)(ws + OFF_CKVCTX))[i] = f2bf(p.cache_d_ckv[i]);
  for (int i = gt; i < 4 * 512 * 32; i += gs) {
    const int b = i >> 14, n = (i >> 5) & 511, d = i & 31;
    ((u16*)(ws + OFF_KPE))[(size_t)(TP + b * NKS + n) * 32 + d] = f2bf(p.cache_d_kpe[i]);
  }
}

template <int MODE>
DI void norm_phase(const Params& p) {
  const int lane = p.tid & 63, wid = p.tid >> 6;
  const float* mod = (const float*)(p.ws + OFF_MOD);
  u16* H = (u16*)(p.ws + OFF_HU);
  const u16* Y = (const u16*)(p.ws + R_Y);
  constexpr int NR = 2;
  const int stride = gridDim.x * 4;
  f32x4 xv[NR][4], xn[NR][4];
  u32x2 yb[NR][4], yn[NR][4];
#define N_LOAD(XV, YB, R0)                                                                           \
  {                                                                                                  \
    _Pragma("unroll") for (int r = 0; r < NR; ++r) {                                                 \
      const int row = (R0) + r * stride;                                                             \
      if (row < T) {                                                                                 \
        const float* xin = (row < TP) ? p.x_prompt + (size_t)row * 1024 : p.x_sample + (size_t)(row - TP) * 1024; \
        const float* xsrc = (MODE == 2) ? p.out + (size_t)row * 1024 : xin;                          \
        _Pragma("unroll") for (int i = 0; i < 4; ++i) {                                              \
          XV[r][i] = __builtin_nontemporal_load((const f32x4*)(xsrc + lane * 4 + 256 * i));          \
          if (MODE != 0) YB[r][i] = __builtin_nontemporal_load((const u32x2*)(Y + (size_t)row * 1024 + lane * 4 + 256 * i)); \
        }                                                                                            \
      }                                                                                              \
    }                                                                                                \
  }
  f32x4 gpost_r[4], gpre_r[4];
#pragma unroll
  for (int i = 0; i < 4; ++i) {
    const int cc = lane * 4 + 256 * i;
    gpost_r[i] = (MODE != 0) ? *(const f32x4*)(p.g_post + (MODE - 1) * 1024 + cc) : f32x4{0.f, 0.f, 0.f, 0.f};
    gpre_r[i] = (MODE != 2) ? *(const f32x4*)(p.g_pre + ((MODE == 0) ? 0 : 1) * 1024 + cc) : f32x4{0.f, 0.f, 0.f, 0.f};
  }
  f32x4 gt_r[4], sc_r[4], sh_r[4];
  int mrow_cached = -1;
  int row0 = p.bid * 4 + wid;
  if (row0 < T) N_LOAD(xv, yb, row0);
  for (; row0 < T; row0 += stride * NR) {
    const int rown = row0 + stride * NR;
    if (rown < T) N_LOAD(xn, yn, rown);
    __builtin_amdgcn_sched_barrier(0);
#pragma unroll
    for (int r = 0; r < NR; ++r) {
      const int row = row0 + r * stride;
      if (row >= T) continue;
      const int mrow = (row < TP) ? 0 : 1 + ((row - TP) >> 12);
      if (mrow != mrow_cached) {
        mrow_cached = mrow;
#pragma unroll
        for (int i = 0; i < 4; ++i) {
          const int cc = lane * 4 + 256 * i;
          if (MODE != 0) gt_r[i] = *(const f32x4*)(mod + ((MODE - 1) * 5 + mrow) * 3072 + 2048 + cc);
          if (MODE != 2) {
            sh_r[i] = *(const f32x4*)(mod + (((MODE == 0) ? 0 : 1) * 5 + mrow) * 3072 + cc);
            sc_r[i] = *(const f32x4*)(mod + (((MODE == 0) ? 0 : 1) * 5 + mrow) * 3072 + 1024 + cc);
          }
        }
      }
      float* orow = p.out + (size_t)row * 1024;
      if (MODE != 0) {
        const int L = MODE - 1;
        const float* gate = mod + (L * 5 + mrow) * 3072 + 2048;
        const float* gpost = p.g_post + L * 1024;
        f32x4 yv[4];
        float ss = 0.f;
#pragma unroll
        for (int i = 0; i < 4; ++i) {
          yv[i][0] = bflo(yb[r][i][0]); yv[i][1] = bfhi(yb[r][i][0]); yv[i][2] = bflo(yb[r][i][1]); yv[i][3] = bfhi(yb[r][i][1]);
#pragma unroll
          for (int e = 0; e < 4; ++e) ss += yv[i][e] * yv[i][e];
        }
        ss = wave_sum(ss);
        const float ry = rsqrtf(ss * (1.f / 1024.f) + EPS);
#pragma unroll
        for (int i = 0; i < 4; ++i) {
          const int cc = lane * 4 + 256 * i;
          const f32x4 gt4 = gt_r[i], gp4 = gpost_r[i];
#pragma unroll
          for (int e = 0; e < 4; ++e) xv[r][i][e] = xv[r][i][e] + gt4[e] * (yv[i][e] * ry * gp4[e]);
          __builtin_nontemporal_store(xv[r][i], (f32x4*)(orow + cc));
        }
        if (MODE == 2) continue;
      }
      const int L2 = (MODE == 0) ? 0 : 1;
      const float* shift = mod + (L2 * 5 + mrow) * 3072;
      const float* scale = shift + 1024;
      const float* gpre = p.g_pre + L2 * 1024;
      float ss = 0.f;
#pragma unroll
      for (int i = 0; i < 4; ++i)
#pragma unroll
        for (int e = 0; e < 4; ++e) ss += xv[r][i][e] * xv[r][i][e];
      ss = wave_sum(ss);
      const float rx = rsqrtf(ss * (1.f / 1024.f) + EPS);
#pragma unroll
      for (int i = 0; i < 4; ++i) {
        const int cc = lane * 4 + 256 * i;
        const f32x4 g4 = gpre_r[i], sc4 = sc_r[i], sh4 = sh_r[i];
        float hv[4];
#pragma unroll
        for (int e = 0; e < 4; ++e) hv[e] = xv[r][i][e] * rx * g4[e] * (1.f + sc4[e]) + sh4[e];
        u32x2 o2; o2[0] = pack2(hv[0], hv[1]); o2[1] = pack2(hv[2], hv[3]);
        *(u32x2*)(H + (size_t)row * 1024 + cc) = o2;
      }
    }
#pragma unroll
    for (int r = 0; r < NR; ++r)
#pragma unroll
      for (int i = 0; i < 4; ++i) { xv[r][i] = xn[r][i]; yb[r][i] = yn[r][i]; }
  }
#undef N_LOAD
}

#define GEMM_XCD_LOOP(MT, NT, EPI_)                                                                  \
  {                                                                                                  \
      \
    constexpr int MX_ = (MT) >> 3;                                                                   \
    constexpr int W_ = ((NT) <= 8) ? (NT) : (((NT) % 6 == 0) ? 6 : 7);                               \
    constexpr int NFULL_ = (NT) / W_;                                                                \
    constexpr int NTC_ = (NT);                                                                       \
    const int xcd_ = p.bid & 7, li_ = p.bid >> 3, nb_ = gridDim.x >> 3;                              \
    GemmPre pre_;                                                                                    \
    bool have_ = false;                                                                              \
    int nmt_ = -1, nnt_ = 0;                                                                         \
    for (int idx_ = (p.bid < nb_ * 8) ? li_ : 0x7fffffff; idx_ < MX_ * (NT); idx_ += nb_) {         \
      int mt_, nt_;                                                                                  \
      if (have_) { mt_ = nmt_; nt_ = nnt_; }                                                         \
      else { GEMM_IDX(idx_, mt_, nt_); }                                                             \
      const int nx_ = idx_ + nb_;                                                                    \
      const bool hn_ = nx_ < MX_ * (NT);                                                             \
      if (hn_) { GEMM_IDX(nx_, nmt_, nnt_); }                                                        \
      gemm_tile<EPI_, AL_PLAIN>(p, j, mt_ * 128, nt_ * 128, smem, pre_, have_, hn_ ? nmt_ * 128 : -1, nnt_ * 128); \
      have_ = hn_;                                                                                   \
    }                                                                                                \
  }
#define GEMM_IDX(i_, mo_, no_)                                                                       \
  {                                                                                                  \
    int win_, rem_, wl_;                                                                             \
    if ((i_) < NFULL_ * MX_ * W_) { win_ = (i_) / (MX_ * W_); rem_ = (i_) % (MX_ * W_); wl_ = W_; }  \
    else { win_ = NFULL_; rem_ = (i_) - NFULL_ * MX_ * W_; wl_ = NTC_ - NFULL_ * W_; }               \
    mo_ = (rem_ / wl_) * 8 + xcd_; no_ = win_ * W_ + rem_ % wl_;                                     \
  }
DI void attn_sample_common(AttnJob& j, int idx, int& b, int& qt, int& h) { b = idx >> 8; const int rem = idx & 255; qt = rem >> 3; h = rem & 7; j.qrow0 = TP + b * 4096 + qt * 128; j.qt2 = qt; }
DI void attn_prompt_common(AttnJob& j, int idx, int& b, int& qt, int& h) { b = idx >> 4; const int rem = idx & 15; qt = rem >> 3; h = rem & 7; j.qrow0 = b * 256 + qt * 128; j.qt2 = 0; }

DI void run_phase(const Params& p, int ph, char* smem) {
  char* ws = p.ws;
  if (!((PHMASK >> ph) & 1)) return;
  switch (ph) {
    case 0: phase0(p, smem); break;
    case 1: norm_phase<0>(p); break;
    case 2: {
      GemmJob j; j.A = (const u16*)(ws + OFF_HU); j.lda = 1024; j.Bt = (const u16*)(ws + OFF_WINE); j.K = 1024; j.grp = 0;
      GEMM_XCD_LOOP(192, 18, EPI_EVEN)
    } break;
    case 3: {
      for (int item = p.bid; item < 1024 + 512 + 768; item += gridDim.x) {
        if (item < 1536) {
          AttnJob j; j.tid = p.tid; int b, qt, h;
          const bool samp = item < 1024;
          if (samp) attn_sample_common(j, item, b, qt, h); else attn_prompt_common(j, item - 1024, b, qt, h);
          const int kvh = h >> 2;
          const int krow0 = samp ? TP + b * NKS : b * 256;
          j.Q = (const u16*)(ws + R_QA) + h * 64; j.q_stride = 512;
          j.K = (const u16*)(ws + R_KA) + (size_t)krow0 * 128 + kvh * 64; j.k_stride = 128; j.K2 = nullptr;
          j.nk = samp ? NKS : 256;
          j.Vt = samp ? (const u16*)(ws + R_VTAS) + (size_t)((b * 2 + kvh) * 64) * NKS : (const u16*)(ws + R_VTAP) + (size_t)((b * 2 + kvh) * 64) * 256;
          j.G = (const u16*)(ws + R_GA) + h * 64;
          j.U = (u16*)(ws + OFF_HU) + h * 64;
          j.ntiles = j.nk / 64; j.sc = 0.125f * LOG2E; j.rpb = nullptr;
          attn_item<64, false>(j, smem);
        } else {
          const int q = item - 1536;
          pool_tile(p, (q >> 2) * 128, q & 3, smem);
        }
      }
    } break;
    case 4: {
      GemmJob j; j.A = (const u16*)(ws + OFF_HU); j.lda = 1024; j.Bt = (const u16*)(ws + OFF_WOUTE); j.K = 1024; j.grp = 0;
      GEMM_XCD_LOOP(192, 8, EPI_Y)
    } break;
    case 5: norm_phase<1>(p); break;
    case 6: {
      GemmJob j; j.A = (const u16*)(ws + OFF_HU); j.lda = 1024; j.Bt = (const u16*)(ws + OFF_WINO); j.K = 1024; j.grp = 0;
      {
        const int gt = p.bid * 256 + p.tid, gs = gridDim.x * 256;
        for (int i0 = gt; i0 < 4 * 512 * 512; i0 += gs * 8) {
          float kv[8], vv[8];
#pragma unroll
          for (int u = 0; u < 8; ++u) {
            const int i = i0 + u * gs;
            if (i < 4 * 512 * 512) { kv[u] = __builtin_nontemporal_load(&p.cache_c_k[i]); vv[u] = __builtin_nontemporal_load(&p.cache_c_v[i]); }
          }
#pragma unroll
          for (int u = 0; u < 8; ++u) {
            const int i = i0 + u * gs;
            if (i < 4 * 512 * 512) {
              const int b = i >> 18, n = (i >> 9) & 511, cc = i & 511;
              ((u16*)(ws + R_KC))[(size_t)(TP + b * NKS + n) * 512 + cc] = f2bf(kv[u]);
              const int hh = cc >> 6, d = cc & 63;
              ((u16*)(ws + R_VTCS))[((size_t)(b * 8 + hh) * 64 + d) * NKS + n] = f2bf(vv[u]);
            }
          }
        }
      }
      GEMM_XCD_LOOP(192, 26, EPI_ODD)
    } break;
    case 7: {
      for (int item = p.bid; item < 1536; item += gridDim.x) {
        AttnJob j; j.tid = p.tid; int b, qt, h;
        const bool samp = item < 1024;
        if (samp) attn_sample_common(j, item, b, qt, h); else attn_prompt_common(j, item - 1024, b, qt, h);
        const int krow0 = samp ? TP + b * NKS : b * 256;
        j.Q = (const u16*)(ws + R_QC) + h * 64; j.q_stride = 512;
        j.K = (const u16*)(ws + R_KC) + (size_t)krow0 * 512 + h * 64; j.k_stride = 512; j.K2 = nullptr;
        j.nk = samp ? NKS : 256;
        j.Vt = samp ? (const u16*)(ws + R_VTCS) + (size_t)((b * 8 + h) * 64) * NKS : (const u16*)(ws + R_VTCP) + (size_t)((b * 8 + h) * 64) * 256;
        j.G = (const u16*)(ws + R_GC) + h * 64;
        j.U = (u16*)(ws + OFF_HU) + h * 64;
        j.sc = 0.125f * LOG2E; j.rpb = p.c_rpb + h * 465;
        if (samp) {
          const int r0e = min(max(2 * qt - 4, 0), 56), r0o = min(max(2 * qt - 3, 0), 56);
          j.ntiles = 8 + (r0o + 8 - r0e);
          attn_item<64, true>(j, smem);
        } else {
          j.ntiles = 4;
          attn_item<64, false>(j, smem);
        }
      }
    } break;
    case 8: {
      {
        const int gt = p.bid * 256 + p.tid, gs = gridDim.x * 256;
        const float* ssq = (const float*)(ws + OFF_SSQ);
        for (int i0 = gt; i0 < TP * 64; i0 += gs * 4) {
          f32x4 ov[4], sv[4], gv[4];
#pragma unroll
          for (int u = 0; u < 4; ++u) {
            const int i = i0 + u * gs;
            if (i < TP * 64) {
              ov[u] = *(const f32x4*)(p.out + O_CKV + (size_t)i * 4);
              sv[u] = *(const f32x4*)(ssq + (size_t)(i >> 6) * 16 + 8);
              gv[u] = *(const f32x4*)(p.d_kv_norm + (i & 63) * 4);
            }
          }
#pragma unroll
          for (int u = 0; u < 4; ++u) {
            const int i = i0 + u * gs;
            if (i < TP * 64) {
              const float r = rsqrtf((sv[u][0] + sv[u][1] + sv[u][2] + sv[u][3]) * (1.f / 256.f) + EPS);
              f32x4 o4;
#pragma unroll
              for (int e = 0; e < 4; ++e) o4[e] = ov[u][e] * r * gv[u][e];
              *(f32x4*)(p.out + O_CKV + (size_t)i * 4) = o4;
            }
          }
        }
      }
      {
        const int xcd = p.bid & 7, li = p.bid >> 3, nb = gridDim.x >> 3;
        for (int idx = (p.bid < nb * 8) ? li : 0x7fffffff; idx < 144 + 192 + 16; idx += nb) {
          GemmJob j; j.grp = 0;
          GemmPre pre0;
          if (idx < 144) {
            j.A = (const u16*)(ws + R_CQ); j.lda = 384; j.Bt = (const u16*)(ws + OFF_WUQ); j.K = 384;
            gemm_tile<EPI_Q, AL_PLAIN>(p, j, ((idx / 6) * 8 + xcd) * 128, (idx % 6) * 128, smem, pre0, false, -1, 0);
          } else if (idx < 144 + 192) {
            const int q = idx - 144;
            j.A = (const u16*)(ws + R_CKV); j.lda = 256; j.Bt = (const u16*)(ws + OFF_WUKVG); j.K = 256;
            gemm_tile<EPI_KV, AL_PLAIN>(p, j, ((q >> 3) * 8 + xcd) * 128, (q & 7) * 128, smem, pre0, false, -1, 0);
          } else {
            const int q = idx - 144 - 192;
            j.A = (const u16*)(ws + OFF_CKVCTX); j.lda = 256; j.Bt = (const u16*)(ws + OFF_WUKV); j.K = 256;
            gemm_tile<EPI_KVCTX, AL_PLAIN>(p, j, ((q >> 3) * 8 + xcd) * 128, (q & 7) * 128, smem, pre0, false, -1, 0);
          }
        }
      }
    } break;
    case 9: {
      for (int item = p.bid; item < 1536; item += gridDim.x) {
        AttnJob j; j.tid = p.tid; int b, qt, h;
        const bool samp = item < 1024;
        if (samp) attn_sample_common(j, item, b, qt, h); else attn_prompt_common(j, item - 1024, b, qt, h);
        const int krow0 = samp ? TP + b * NKS : b * 256;
        j.Q = (const u16*)(ws + R_QD) + h * 96; j.q_stride = 768;
        j.K = (const u16*)(ws + R_KD) + (size_t)krow0 * 512 + h * 64; j.k_stride = 512;
        j.K2 = (const u16*)(ws + OFF_KPE) + (size_t)krow0 * 32;
        j.nk = samp ? NKS : 256;
        j.Vt = samp ? (const u16*)(ws + R_VTDS) + (size_t)((b * 8 + h) * 64) * NKS : (const u16*)(ws + R_VTDP) + (size_t)((b * 8 + h) * 64) * 256;
        j.G = (const u16*)(ws + R_GD) + h * 64;
        j.U = (u16*)(ws + OFF_HU) + 512 + h * 64;
        j.ntiles = j.nk / 64; j.sc = 0.10206207261596575f * LOG2E; j.rpb = nullptr;
        attn_item<96, false>(j, smem);
      }
    } break;
    case 10: {
      GemmJob j; j.A = (const u16*)(ws + OFF_HU); j.lda = 1024; j.Bt = (const u16*)(ws + OFF_WOUTO); j.K = 1024; j.grp = 0;
      GEMM_XCD_LOOP(192, 8, EPI_Y)
    } break;
    case 11: norm_phase<2>(p); break;
  }
}

#define XB_TMO      128
#define XB_XCNT(j)  (256  + 64 * (j))
#define XB_XSUB(j)  (1280 + 64 * (j))
#define XB_XGEN(j)  (2304 + 64 * (j))
#define XB_TOP      3328
#define XB_TOPGEN   3392
#define XCD_BAR_WORDS 3456
#define XB_SPIN_CAP (1u << 18)
#define LAS __attribute__((address_space(3)))

__device__ __forceinline__ unsigned xb_ld(unsigned* p)              { return __hip_atomic_load(p, __ATOMIC_RELAXED, __HIP_MEMORY_SCOPE_AGENT); }
__device__ __forceinline__ unsigned xb_add(unsigned* p, unsigned v) { return __hip_atomic_fetch_add(p, v, __ATOMIC_RELAXED, __HIP_MEMORY_SCOPE_AGENT); }
__device__ __forceinline__ unsigned xb_xcc_id() { return (unsigned)__builtin_amdgcn_s_getreg((3 << 11) | 20) & 0xFu; }
#define XB_SPIN(cond, bar) do { unsigned _sp = 0; while (cond) { __builtin_amdgcn_s_sleep(1); \
    if ((++_sp & 255u) == 0u) { if (xb_ld(&(bar)[XB_TMO])) break; if (_sp > XB_SPIN_CAP) { atomicAdd(&(bar)[XB_TMO], 1u); break; } } } } while (0)

struct XcdBarrier {
    unsigned* bar; unsigned x;
    volatile LAS unsigned* st;
};

__device__ __forceinline__ XcdBarrier xcd_barrier_post(unsigned* bar, volatile LAS unsigned* st) {
    XcdBarrier b; b.bar = bar; b.x = xb_xcc_id(); b.st = st;
    if (threadIdx.x == 0) (void)xb_add(&bar[XB_XCNT(b.x)], 1u);
    return b;
}
__device__ __forceinline__ void xcd_barrier_complete(unsigned* bar, unsigned x, unsigned& nloc, unsigned& nx) {
    const unsigned G = gridDim.x * gridDim.y * gridDim.z;
    unsigned sum, cnt, mine, sp = 0u;
    for (;;) {
        sum = 0u; cnt = 0u; mine = 0u;
#pragma unroll
        for (unsigned j = 0; j < 16; ++j) { const unsigned c = xb_ld(&bar[XB_XCNT(j)]); sum += c; cnt += (c > 0u) ? 1u : 0u; mine = (j == x) ? c : mine; }
        if (sum == G) break;
        __builtin_amdgcn_s_sleep(1);
        if ((++sp & 255u) == 0u) { if (xb_ld(&bar[XB_TMO])) break; if (sp > XB_SPIN_CAP) { atomicAdd(&bar[XB_TMO], 1u); break; } }
    }
    nloc = mine > 0u ? mine : 1u; nx = cnt > 0u ? cnt : 1u;
}

__device__ __forceinline__ void xcd_barrier(const XcdBarrier& b) {
    asm volatile("s_waitcnt vmcnt(0)" ::: "memory");
    __syncthreads();
    if (threadIdx.x == 0) {
        unsigned* bar = b.bar;
        __builtin_amdgcn_s_waitcnt(0);
        unsigned nloc = b.st[0], nx = b.st[1];
        if (nloc == 0u) { xcd_barrier_complete(bar, b.x, nloc, nx); b.st[0] = nloc; b.st[1] = nx; }
        const unsigned old = xb_add(&bar[XB_XSUB(b.x)], 1u);
        const unsigned gen = old / nloc;
        if (old + 1u == (gen + 1u) * nloc) {
            __builtin_amdgcn_fence(__ATOMIC_RELEASE, "agent");
            asm volatile("s_waitcnt vmcnt(0)" ::: "memory");
            const unsigned og = xb_add(&bar[XB_TOP], 1u);
            const unsigned tg = og / nx;
            if (og + 1u == (tg + 1u) * nx) xb_add(&bar[XB_TOPGEN], 1u);
            else XB_SPIN(xb_ld(&bar[XB_TOPGEN]) == tg, bar);
            __builtin_amdgcn_fence(__ATOMIC_ACQUIRE, "agent");
            xb_add(&bar[XB_XGEN(b.x)], 1u);
            asm volatile("s_waitcnt vmcnt(0)" ::: "memory");
        } else {
            XB_SPIN(xb_ld(&bar[XB_XGEN(b.x)]) == gen, bar);
            __builtin_amdgcn_fence(__ATOMIC_ACQUIRE, "agent");
            asm volatile("s_waitcnt vmcnt(0)" ::: "memory");
        }
    }
    __syncthreads();
}


__global__ void __launch_bounds__(256, 2) mega(Params p0, int ph_lo, int ph_hi) {
  __shared__ __attribute__((aligned(16))) char smem[SMEM_BYTES];
  __shared__ uint4 xb_words;
  if (threadIdx.x == 0) xb_words = make_uint4(0u, 0u, 0u, 0u);
  __syncthreads();
  XcdBarrier xb = xcd_barrier_post((unsigned*)(p0.ws + OFF_BAR), (volatile LAS unsigned*)&xb_words);
  int ph_rep = 0;
  for (int ph = ph_lo; ph < ph_hi; ++ph) {
    Params p = p0;
#define GP(f) p.f = (const float*)(const GLOBAL float*)p0.f;
    GP(x_prompt) GP(x_sample) GP(cache_a_k) GP(cache_a_v) GP(cache_c_k) GP(cache_c_v) GP(cache_d_ckv) GP(cache_d_kpe)
    GP(c) GP(c_ctx) GP(w_mod) GP(b_mod) GP(g_pre) GP(g_post) GP(w_in_e) GP(a_q_norm) GP(a_k_norm) GP(b_map) GP(b_scale) GP(w_out_e)
    GP(w_in_o) GP(c_rpb) GP(d_q_norm) GP(d_w_uq) GP(d_kv_norm) GP(d_w_ukv) GP(w_out_o)
#undef GP
    int tid = threadIdx.x, bid = blockIdx.x;
    GLOBAL char* ws = (GLOBAL char*)p0.ws; GLOBAL float* out = (GLOBAL float*)p0.out;
    asm volatile("" : "+v"(tid));
    asm volatile("" : "+s"(bid));
    asm volatile("" : "+s"(ws));
    asm volatile("" : "+s"(out));
    p.tid = tid; p.bid = bid; p.ws = (char*)ws; p.out = (float*)out;
#if REPEAT_MASK
    if ((REPEAT_MASK >> ph) & 1) ph_rep ^= 1;
#endif
    run_phase(p, ph, smem);
#if REPEAT_MASK
    if (ph_rep) { --ph; xcd_barrier(xb); continue; }
#endif
    if (ph + 1 < ph_hi) xcd_barrier(xb);
    if (ph_hi < 0) cg::this_grid().sync();
  }
}

extern "C" void kernel_launch(void* const* d_in, const int* in_sizes, int n_in, void* d_out, int out_size, void* d_ws, size_t ws_size, hipStream_t stream) {
  static int grid = 0;
  if (!grid) {
    int dev = 0, cus = 0, per_cu = 0;
    hipGetDevice(&dev);
    hipDeviceGetAttribute(&cus, hipDeviceAttributeMultiprocessorCount, dev);
    hipOccupancyMaxActiveBlocksPerMultiprocessor(&per_cu, mega, 256, 0);
    if (per_cu < 1) per_cu = 1;
    if (per_cu > 2) per_cu = 2;
    grid = cus * per_cu;
    if (ws_size < WS_LIMIT + 16384) fprintf(stderr, "kernel_launch: ws too small (%zu)\n", ws_size);
  }
  Params p{};
  const float** pp = (const float**)&p;
  for (int i = 0; i < 27; ++i) pp[i] = (const float*)d_in[i];
  p.out = (float*)d_out;
  p.ws = (char*)d_ws;
#if MK_COOP
  hipMemsetAsync((char*)d_ws + OFF_MOD, 0, 2 * 5 * 3072 * 4 + XCD_BAR_WORDS * 4, stream);
  int lo = 0, hi = NPHASE;
  void* args[] = {&p, &lo, &hi};
  hipError_t e = hipLaunchCooperativeKernel((void*)mega, dim3(grid), dim3(256), args, 0, stream);
  if (e != hipSuccess) fprintf(stderr, "cooperative launch failed: %s (grid %d)\n", hipGetErrorString(e), grid);
#else
  for (int ph = 0; ph < NPHASE; ++ph) hipLaunchKernelGGL(mega, dim3(grid), dim3(256), 0, stream, p, ph, ph + 1);
#endif
}
```
